# Optimizing an MI355X kernel written in HIP

```python
import math
import jax
import jax.numpy as jnp
from jax import lax
import numpy as np

D_MODEL = 1024
BATCH = 16
SEQ = 2048
DEPTH = 4

CTX_LEN = 256
GRID_W = 64
HEAD_DIM = 64
NA_HEADS = D_MODEL // (2 * HEAD_DIM)
NA_KH = 8
NA_KW = 16
DIFF_HEADS = D_MODEL // (4 * HEAD_DIM)
DIFF_VDIM = 2 * HEAD_DIM
GQA_Q_HEADS = D_MODEL // HEAD_DIM
GQA_KV_HEADS = 4
GQA_GROUP = GQA_Q_HEADS // GQA_KV_HEADS
D_FF = 2816
CONV_WIDTH = 3
Q_BLOCK = 128
ROPE_BASE = 10000.0
EPS = 1e-6
N_EVEN = (DEPTH + 1) // 2
N_ODD = DEPTH // 2
ALPHA = (2 * DEPTH) ** 0.25
BETA = (8 * DEPTH) ** -0.25
NA_W = NA_HEADS * HEAD_DIM
DIFF_W = DIFF_HEADS * 2 * HEAD_DIM
GQA_QW = GQA_Q_HEADS * HEAD_DIM
GQA_KW = GQA_KV_HEADS * HEAD_DIM

kernel_name = 'hybrid_natten_diff_gqa_convffn_dit'


def layer_norm(x, g, b):
    xf = x.astype(jnp.float32)
    mu = jnp.mean(xf, -1, keepdims=True)
    var = jnp.mean(jnp.square(xf - mu), -1, keepdims=True)
    return ((xf - mu) * lax.rsqrt(var + EPS)).astype(x.dtype) * g + b


def rms_norm(x, g):
    xf = x.astype(jnp.float32)
    return (xf * lax.rsqrt(jnp.mean(xf * xf, -1, keepdims=True) + EPS)).astype(x.dtype) * g


def softmax_f32(s):
    return jax.nn.softmax(s.astype(jnp.float32), axis=-1)


def modulate(x, shift, scale):
    return x * (1.0 + scale) + shift


def heads(t, n):
    b, t_len, _ = t.shape
    return t.reshape(b, t_len, n, -1).transpose(0, 2, 1, 3)


def merge_heads(t):
    b, n, t_len, d = t.shape
    return t.transpose(0, 2, 1, 3).reshape(b, t_len, n * d)


def rope_2d_tables(n_tokens, dtype):
    n_freq = HEAD_DIM // 4
    inv = ROPE_BASE ** (-jnp.arange(n_freq, dtype=jnp.float32) / n_freq)
    t = jnp.arange(n_tokens)
    row = (t // GRID_W).astype(jnp.float32)
    col = (t % GRID_W).astype(jnp.float32)
    ar = row[:, None] * inv
    ac = col[:, None] * inv
    ang = jnp.concatenate([ar, ar, ac, ac], -1)
    return jnp.cos(ang).astype(dtype), jnp.sin(ang).astype(dtype)


def apply_rope_2d(x, cos, sin):
    x1, x2, x3, x4 = jnp.split(x, 4, axis=-1)
    rot = jnp.concatenate([-x2, x1, -x4, x3], -1)
    return x * cos + rot * sin


def block_attention(q, k, v, scale):
    b, hk, g, s, d = q.shape
    nb = s // Q_BLOCK
    qb = jnp.moveaxis(q.reshape(b, hk, g, nb, Q_BLOCK, d), 3, 0)

    def one_block(qi):
        p = softmax_f32(jnp.einsum('bhgqd,bhkd->bhgqk', qi, k).astype(jnp.float32) * scale)
        return jnp.einsum('bhgqk,bhkd->bhgqd', p.astype(v.dtype), v)

    out = lax.map(one_block, qb)
    return jnp.moveaxis(out, 0, 3).reshape(b, hk, g, s, v.shape[-1])


def diff_block_attention(q1, q2, k1, k2, v, lam, scale):
    b, h, s, d = q1.shape
    nb = s // Q_BLOCK

    def to_blocks(t):
        return jnp.moveaxis(t.reshape(b, h, nb, Q_BLOCK, d), 2, 0)

    def one_block(qs):
        a1, a2 = qs
        p1 = softmax_f32(jnp.einsum('bhqd,bhkd->bhqk', a1, k1).astype(jnp.float32) * scale)
        p2 = softmax_f32(jnp.einsum('bhqd,bhkd->bhqk', a2, k2).astype(jnp.float32) * scale)
        return jnp.einsum('bhqk,bhkd->bhqd', (p1 - lam * p2).astype(v.dtype), v)

    out = lax.map(one_block, (to_blocks(q1), to_blocks(q2)))
    return jnp.moveaxis(out, 0, 2).reshape(b, h, s, v.shape[-1])


def neighbourhood_attention(q, k, v, kc, vc, rpb, scale):
    b, h, s, d = q.shape
    rows = s // GRID_W
    kh = min(NA_KH, rows)
    r = jnp.arange(rows)
    c = jnp.arange(GRID_W)
    row_start = jnp.clip(r - kh // 2, 0, rows - kh)
    col_start = jnp.clip(c - NA_KW // 2, 0, GRID_W - NA_KW)
    col_ok = (c[None, :] >= col_start[:, None]) & (c[None, :] < col_start[:, None] + NA_KW)
    dc_idx = jnp.clip(c[None, :] - c[:, None] + NA_KW - 1, 0, 2 * NA_KW - 2)
    bias_col = jnp.where(col_ok, rpb[:, :, dc_idx].astype(jnp.float32), -jnp.inf)
    k_grid = k.reshape(b, h, rows, GRID_W, d)
    v_grid = v.reshape(b, h, rows, GRID_W, d)
    q_rows = jnp.moveaxis(q.reshape(b, h, rows, GRID_W, d), 2, 0)
    n_loc = kh * GRID_W

    def one_row(args):
        qr, ri, rs = args
        kr = lax.dynamic_slice_in_dim(k_grid, rs, kh, axis=2)
        vr = lax.dynamic_slice_in_dim(v_grid, rs, kh, axis=2)
        bias = bias_col[:, rs + jnp.arange(kh) - ri + NA_KH - 1]
        s_loc = jnp.einsum('bhqd,bhikd->bhqik', qr, kr).astype(jnp.float32) * scale \
            + jnp.transpose(bias, (0, 2, 1, 3))[None]
        s_ctx = jnp.einsum('bhqd,bhld->bhql', qr, kc).astype(jnp.float32) * scale
        p = softmax_f32(jnp.concatenate([s_loc.reshape(b, h, GRID_W, n_loc), s_ctx], -1)).astype(v.dtype)
        return (jnp.einsum('bhqk,bhkd->bhqd', p[..., :n_loc], vr.reshape(b, h, n_loc, d))
                + jnp.einsum('bhql,bhld->bhqd', p[..., n_loc:], vc))

    out = lax.map(one_row, (q_rows, r, row_start))
    return jnp.moveaxis(out, 0, 2).reshape(b, h, s, d)


def mixer_ab(h, hc, w_in, w_o, rpb, lam_vec, subln_g, lambda_init, rope, need_ctx):
    cos, sin = rope
    scale = HEAD_DIM ** -0.5
    lv = lam_vec.astype(jnp.float32)
    lam = jnp.exp(jnp.sum(lv[0] * lv[1])) - jnp.exp(jnp.sum(lv[2] * lv[3])) + lambda_init
    splits = [NA_W, 2 * NA_W, 3 * NA_W, 3 * NA_W + DIFF_W, 3 * NA_W + 2 * DIFF_W]

    def project(t):
        nq, nk, nv, dq, dk, dv = jnp.split(t @ w_in, splits, axis=-1)
        return (heads(nq, NA_HEADS), heads(nk, NA_HEADS), heads(nv, NA_HEADS),
                heads(dq, 2 * DIFF_HEADS), heads(dk, 2 * DIFF_HEADS), heads(dv, DIFF_HEADS))

    def diff_post(o):
        return rms_norm(o, subln_g) * (1.0 - lambda_init)

    def out_proj(na_o, diff_o):
        return jnp.concatenate([merge_heads(na_o), merge_heads(diff_o)], -1) @ w_o

    nq, nk, nv, dq, dk, dv = project(h)
    cnq, cnk, cnv, cdq, cdk, cdv = project(hc)
    na = neighbourhood_attention(nq, nk, nv, cnk, cnv, rpb, scale)
    dq = apply_rope_2d(dq, cos, sin)
    dk = apply_rope_2d(dk, cos, sin)
    k1 = jnp.concatenate([dk[:, 0::2], cdk[:, 0::2]], axis=2)
    k2 = jnp.concatenate([dk[:, 1::2], cdk[:, 1::2]], axis=2)
    v_all = jnp.concatenate([dv, cdv], axis=2)
    diff = diff_post(diff_block_attention(dq[:, 0::2], dq[:, 1::2], k1, k2, v_all, lam, scale))
    y = out_proj(na, diff)
    if not need_ctx:
        return y, None
    na_c = block_attention(cnq[:, :, None], cnk, cnv, scale)[:, :, 0]
    diff_c = diff_post(diff_block_attention(cdq[:, 0::2], cdq[:, 1::2], cdk[:, 0::2], cdk[:, 1::2], cdv, lam, scale))
    return y, out_proj(na_c, diff_c)


def mixer_c(h, hc, w_in, w_o, qk_g, rope, need_ctx):
    cos, sin = rope
    scale = HEAD_DIM ** -0.5

    def project(t):
        b, t_len, _ = t.shape
        q, k, v = jnp.split(t @ w_in, [GQA_QW, GQA_QW + GQA_KW], axis=-1)
        q = rms_norm(heads(q, GQA_Q_HEADS), qk_g[0]).reshape(b, GQA_KV_HEADS, GQA_GROUP, t_len, HEAD_DIM)
        k = rms_norm(heads(k, GQA_KV_HEADS), qk_g[1])
        return q, k, heads(v, GQA_KV_HEADS)

    def out_proj(o):
        b, _, _, t_len, _ = o.shape
        return merge_heads(o.reshape(b, GQA_Q_HEADS, t_len, HEAD_DIM)) @ w_o

    q, k, v = project(h)
    cq, ck, cv = project(hc)
    q = apply_rope_2d(q, cos, sin)
    k = apply_rope_2d(k, cos, sin)
    y = out_proj(block_attention(q, jnp.concatenate([k, ck], 2), jnp.concatenate([v, cv], 2), scale))
    if not need_ctx:
        return y, None
    return y, out_proj(block_attention(cq, ck, cv, scale))


def conv_ffn(h, w_up, conv_w, conv_b, w_down):
    t_len = h.shape[1]
    pad = CONV_WIDTH // 2
    up = jnp.pad(h @ w_up, ((0, 0), (pad, pad), (0, 0)))
    u = sum(up[:, j:j + t_len] * conv_w[j] for j in range(CONV_WIDTH)) + conv_b
    a, g = jnp.split(u, 2, axis=-1)
    return (jax.nn.gelu(g) * a) @ w_down


def setup_inputs(seed: int = 0) -> dict:
    key = jax.random.key(seed)
    ks = jax.random.split(key, 32)
    f32 = jnp.float32
    D = D_MODEL

    def nrm(k, shape, s):
        return jax.random.normal(k, shape, f32) * s

    sd = D ** -0.5
    return {
        'x': nrm(ks[0], (BATCH, SEQ, D), 1.0),
        'c': nrm(ks[1], (BATCH, D), 1.0),
        'ctx': nrm(ks[2], (BATCH, CTX_LEN, D), 1.0),
        'c_ctx': nrm(ks[3], (D,), 1.0),
        'w_ada': nrm(ks[4], (DEPTH, D, 6 * D), sd),
        'b_ada': nrm(ks[5], (DEPTH, 6 * D), 0.02),
        'ln_g': 1.0 + nrm(ks[6], (DEPTH, 2, D), 0.02),
        'ln_b': nrm(ks[7], (DEPTH, 2, D), 0.02),
        'w_in_ab': jnp.concatenate([
            nrm(ks[8], (N_EVEN, D, 2 * NA_W), sd),
            nrm(ks[9], (N_EVEN, D, NA_W), BETA * sd),
            nrm(ks[10], (N_EVEN, D, 2 * DIFF_W), sd),
            nrm(ks[11], (N_EVEN, D, DIFF_HEADS * DIFF_VDIM), BETA * sd)], axis=-1),
        'w_o_ab': nrm(ks[12], (N_EVEN, NA_W + DIFF_HEADS * DIFF_VDIM, D), BETA * sd),
        'na_rpb': nrm(ks[13], (N_EVEN, NA_HEADS, 2 * NA_KH - 1, 2 * NA_KW - 1), 0.1),
        'diff_lambda': nrm(ks[14], (N_EVEN, 4, HEAD_DIM), 0.1),
        'diff_subln': 1.0 + nrm(ks[15], (N_EVEN, DIFF_VDIM), 0.02),
        'w_in_c': jnp.concatenate([
            nrm(ks[16], (N_ODD, D, GQA_QW + GQA_KW), sd),
            nrm(ks[17], (N_ODD, D, GQA_KW), BETA * sd)], axis=-1),
        'w_o_c': nrm(ks[18], (N_ODD, GQA_QW, D), BETA * GQA_QW ** -0.5),
        'gqa_qk_norm': 1.0 + nrm(ks[19], (N_ODD, 2, HEAD_DIM), 0.02),
        'w_up': nrm(ks[20], (DEPTH, D, 2 * D_FF), BETA * sd),
        'conv_w': nrm(ks[21], (DEPTH, CONV_WIDTH, 2 * D_FF), CONV_WIDTH ** -0.5),
        'conv_b': nrm(ks[22], (DEPTH, 2 * D_FF), 0.02),
        'w_down': nrm(ks[23], (DEPTH, D_FF, D), BETA * D_FF ** -0.5),
    }


def reference(x, c, ctx, c_ctx, w_ada, b_ada, ln_g, ln_b, w_in_ab, w_o_ab, na_rpb, diff_lambda,
              diff_subln, w_in_c, w_o_c, gqa_qk_norm, w_up, conv_w, conv_b, w_down):
    rope = rope_2d_tables(x.shape[1], x.dtype)
    cond = jax.nn.silu(c)
    cond_ctx = jax.nn.silu(c_ctx)
    xc = ctx
    for l in range(DEPTH):
        need_ctx = l < DEPTH - 1
        mod = jnp.split((cond @ w_ada[l] + b_ada[l])[:, None, :], 6, axis=-1)
        mod_c = jnp.split(cond_ctx @ w_ada[l] + b_ada[l], 6, axis=-1)
        h = modulate(x, mod[0], mod[1])
        hc = modulate(xc, mod_c[0], mod_c[1])
        if l % 2 == 0:
            i = l // 2
            lambda_init = 0.8 - 0.6 * math.exp(-0.3 * l)
            y, yc = mixer_ab(h, hc, w_in_ab[i], w_o_ab[i], na_rpb[i], diff_lambda[i], diff_subln[i],
                             lambda_init, rope, need_ctx)
        else:
            i = l // 2
            y, yc = mixer_c(h, hc, w_in_c[i], w_o_c[i], gqa_qk_norm[i], rope, need_ctx)
        x = layer_norm(ALPHA * x + mod[2] * y, ln_g[l, 0], ln_b[l, 0])
        f = conv_ffn(modulate(x, mod[3], mod[4]), w_up[l], conv_w[l], conv_b[l], w_down[l])
        x = layer_norm(ALPHA * x + mod[5] * f, ln_g[l, 1], ln_b[l, 1])
        if need_ctx:
            xc = layer_norm(ALPHA * xc + mod_c[2] * yc, ln_g[l, 0], ln_b[l, 0])
            fc = conv_ffn(modulate(xc, mod_c[3], mod_c[4]), w_up[l], conv_w[l], conv_b[l], w_down[l])
            xc = layer_norm(ALPHA * xc + mod_c[5] * fc, ln_g[l, 1], ln_b[l, 1])
    return x
```

```cpp
#include <hip/hip_runtime.h>
#include <hip/hip_cooperative_groups.h>
#include <cstdio>
namespace cg = cooperative_groups;

#ifndef PROBE
#define PROBE 0
#endif
#ifndef USE_XCD_BARRIER
#define USE_XCD_BARRIER 1
#endif
#ifndef MK_MULTI
#define MK_MULTI 0
#endif

#define DI __device__ __forceinline__
typedef unsigned short u16;
typedef __attribute__((ext_vector_type(8))) __bf16 bf8;
typedef __attribute__((ext_vector_type(2))) __bf16 bf2;
typedef __attribute__((ext_vector_type(2))) float f2;
typedef __attribute__((ext_vector_type(16))) float f32x16;
typedef __attribute__((ext_vector_type(4))) _Float16 h4;
typedef __attribute__((ext_vector_type(8))) _Float16 h8;
typedef __attribute__((ext_vector_type(4))) unsigned u32x4;
typedef __attribute__((ext_vector_type(2))) unsigned u32x2;
typedef __attribute__((ext_vector_type(4))) float f32x4n;
typedef __attribute__((ext_vector_type(2))) float f32x2n;

constexpr int NLAT = 32768, NCTX = 4096, NROWS = 36864, T = 2304, DFF = 2816;
constexpr float ALPHA = 1.681792830507429f;
constexpr float EPS = 1e-6f;
constexpr float LOG2E = 1.4426950408889634f;

constexpr size_t OFF_MODS = 0;
constexpr size_t OFF_ROPE = OFF_MODS + 1671168;
constexpr size_t OFF_LAM = OFF_ROPE + 8192;
constexpr size_t OFF_WIN_E = OFF_LAM + 256;
constexpr size_t OFF_WIN_O = OFF_WIN_E + 12582912;
constexpr size_t OFF_WO = OFF_WIN_O + 6291456;
constexpr size_t OFF_WUP = OFF_WO + 8388608;
constexpr size_t OFF_WD = OFF_WUP + 46137344;
constexpr size_t OFF_X = OFF_WD + 23068672;
constexpr size_t OFF_H = OFF_X + 75497472;
constexpr size_t OFF_QO = OFF_H + 75497472;
constexpr size_t OFF_K = OFF_QO + 75497472;
constexpr size_t OFF_VT = OFF_K + 75497472;
constexpr size_t OFF_END = OFF_VT + 75497472;
constexpr size_t OFF_ACT = OFF_QO;
constexpr size_t OFF_BAR = OFF_END;
constexpr size_t WS_NEEDED = OFF_BAR + 16384;

constexpr int SMEM_BYTES = 131072 + 4096;
constexpr int NTHR = 512, NWAVE = 8;

struct Params {
  const float *x, *c, *ctx, *c_ctx, *w_ada, *b_ada, *ln_g, *ln_b, *w_in_ab, *w_o_ab, *na_rpb, *diff_lambda, *diff_subln,
      *w_in_c, *w_o_c, *gqa_qk_norm, *w_up, *conv_w, *conv_b, *w_down;
  float* out;
  char* ws;
};

DI unsigned pack2(float a, float b) { f2 v = {a, b}; bf2 r = __builtin_convertvector(v, bf2); return __builtin_bit_cast(unsigned, r); }
DI u16 f2bf(float a) { __bf16 b = (__bf16)a; return __builtin_bit_cast(u16, b); }
DI int crow(int i, int h) { return (i & 3) + 8 * (i >> 2) + 4 * h; }
DI f32x16 mfma32(bf8 a, bf8 b, f32x16 c) { return __builtin_amdgcn_mfma_f32_32x32x16_bf16(a, b, c, 0, 0, 0); }
DI int tid() { int t; asm volatile("v_mov_b32 %0, %1" : "=v"(t) : "v"((int)threadIdx.x)); return t; }
DI int bid() { int b; asm volatile("s_mov_b32 %0, %1" : "=s"(b) : "s"((int)blockIdx.x)); return b; }
typedef __attribute__((address_space(3))) char lds_char;
DI void glds16(const void* gptr, unsigned lds_addr) {
  asm volatile("s_mov_b32 m0, %0\n\ts_nop 0\n\tglobal_load_lds_dwordx4 %1, off" ::"s"(lds_addr), "v"(gptr) : "memory");
}
DI float ex2(float x) { return __builtin_amdgcn_exp2f(x); }
DI float shx(float v, int lane, int mask) { return __int_as_float(__builtin_amdgcn_ds_bpermute((lane ^ mask) << 2, __float_as_int(v))); }
DI float shi(float v, int src) { return __int_as_float(__builtin_amdgcn_ds_bpermute(src << 2, __float_as_int(v))); }
DI float wave_sum(float v, int lane) {
#pragma unroll
  for (int o = 1; o < 64; o <<= 1) v += shx(v, lane, o);
  return v;
}

#define XB_TMO      128
#define XB_XCNT(j)  (256  + 64 * (j))
#define XB_XSUB(j)  (1280 + 64 * (j))
#define XB_XGEN(j)  (2304 + 64 * (j))
#define XB_TOP      3328
#define XB_TOPGEN   3392
#define XCD_BAR_WORDS 3456
#define XB_SPIN_CAP (1u << 18)
#define LAS __attribute__((address_space(3)))
DI unsigned xb_ld(unsigned* p) { return __hip_atomic_load(p, __ATOMIC_RELAXED, __HIP_MEMORY_SCOPE_AGENT); }
DI unsigned xb_add(unsigned* p, unsigned v) { return __hip_atomic_fetch_add(p, v, __ATOMIC_RELAXED, __HIP_MEMORY_SCOPE_AGENT); }
DI unsigned xb_xcc_id() { return (unsigned)__builtin_amdgcn_s_getreg((3 << 11) | 20) & 0xFu; }
#define XB_SPIN(cond, bar) do { unsigned _sp = 0; while (cond) { __builtin_amdgcn_s_sleep(1); \
    if ((++_sp & 255u) == 0u) { if (xb_ld(&(bar)[XB_TMO])) break; if (_sp > XB_SPIN_CAP) { atomicAdd(&(bar)[XB_TMO], 1u); break; } } } } while (0)
struct XcdBarrier { unsigned* bar; unsigned x; volatile LAS unsigned* st; };
DI XcdBarrier xcd_barrier_post(unsigned* bar, volatile LAS unsigned* st) {
  XcdBarrier b; b.bar = bar; b.x = xb_xcc_id(); b.st = st;
  if (threadIdx.x == 0) (void)xb_add(&bar[XB_XCNT(b.x)], 1u);
  return b;
}
DI void xcd_barrier_complete(unsigned* bar, unsigned x, unsigned& nloc, unsigned& nx) {
  const unsigned G = gridDim.x * gridDim.y * gridDim.z;
  unsigned sum, cnt, mine, sp = 0u;
  for (;;) {
    sum = 0u; cnt = 0u; mine = 0u;
#pragma unroll
    for (unsigned j = 0; j < 16; ++j) { const unsigned c = xb_ld(&bar[XB_XCNT(j)]); sum += c; cnt += (c > 0u) ? 1u : 0u; mine = (j == x) ? c : mine; }
    if (sum == G) break;
    __builtin_amdgcn_s_sleep(1);
    if ((++sp & 255u) == 0u) { if (xb_ld(&bar[XB_TMO])) break; if (sp > XB_SPIN_CAP) { atomicAdd(&bar[XB_TMO], 1u); break; } }
  }
  nloc = mine > 0u ? mine : 1u; nx = cnt > 0u ? cnt : 1u;
}
DI void xcd_barrier(const XcdBarrier& b) {
  asm volatile("s_waitcnt vmcnt(0)" ::: "memory");
  __syncthreads();
  if (threadIdx.x == 0) {
    unsigned* bar = b.bar;
    __builtin_amdgcn_s_waitcnt(0);
    unsigned nloc = b.st[0], nx = b.st[1];
    if (nloc == 0u) { xcd_barrier_complete(bar, b.x, nloc, nx); b.st[0] = nloc; b.st[1] = nx; }
    const unsigned old = xb_add(&bar[XB_XSUB(b.x)], 1u);
    const unsigned gen = old / nloc;
    if (old + 1u == (gen + 1u) * nloc) {
      __builtin_amdgcn_fence(__ATOMIC_RELEASE, "agent");
      asm volatile("s_waitcnt vmcnt(0)" ::: "memory");
      const unsigned og = xb_add(&bar[XB_TOP], 1u);
      const unsigned tg = og / nx;
      if (og + 1u == (tg + 1u) * nx) xb_add(&bar[XB_TOPGEN], 1u);
      else XB_SPIN(xb_ld(&bar[XB_TOPGEN]) == tg, bar);
      __builtin_amdgcn_fence(__ATOMIC_ACQUIRE, "agent");
      xb_add(&bar[XB_XGEN(b.x)], 1u);
      asm volatile("s_waitcnt vmcnt(0)" ::: "memory");
    } else {
      XB_SPIN(xb_ld(&bar[XB_XGEN(b.x)]) == gen, bar);
      __builtin_amdgcn_fence(__ATOMIC_ACQUIRE, "agent");
      asm volatile("s_waitcnt vmcnt(0)" ::: "memory");
    }
  }
  __syncthreads();
}

DI void phase0_mods(const Params& p, char* smem) {
  float* condS = (float*)smem;
  float* red = (float*)(smem + 17 * 512 * 4);
  float* mods = (float*)(p.ws + OFF_MODS);
  const int t = tid(), lane = t & 63, w = __builtin_amdgcn_readfirstlane(t >> 6);
  const int cq = t & 15, kg = t >> 4;
  for (int item = bid(); item < 4 * 96; item += gridDim.x) {
    const int l = item / 96, cb = item % 96;
    const int col = cb * 64 + cq * 4;
    float acc[17][4];
#pragma unroll
    for (int i = 0; i < 17; ++i) { acc[i][0] = 0.f; acc[i][1] = 0.f; acc[i][2] = 0.f; acc[i][3] = 0.f; }
    for (int kh = 0; kh < 2; ++kh) {
      __syncthreads();
      for (int e = t; e < 17 * 512; e += NTHR) {
        const int i = e >> 9, k = (e & 511) + kh * 512;
        const float v = (i < 16) ? p.c[i * 1024 + k] : p.c_ctx[k];
        condS[e] = v / (1.f + __expf(-v));
      }
      __syncthreads();
      const float* wp = p.w_ada + ((size_t)l * 1024 + kh * 512 + kg * 16) * 6144 + col;
#pragma unroll 2
      for (int kk = 0; kk < 16; ++kk) {
        const f32x4n wv = *(const f32x4n*)(wp + (size_t)kk * 6144);
#pragma unroll
        for (int i = 0; i < 17; ++i) {
          const float cv = condS[i * 512 + kg * 16 + kk];
          acc[i][0] += cv * wv.x; acc[i][1] += cv * wv.y; acc[i][2] += cv * wv.z; acc[i][3] += cv * wv.w;
        }
      }
    }
#pragma unroll
    for (int i = 0; i < 17; ++i)
#pragma unroll
      for (int j = 0; j < 4; ++j) {
        float v = acc[i][j];
        v += shx(v, lane, 16);
        v += shx(v, lane, 32);
        acc[i][j] = v;
      }
    __syncthreads();
    if (lane < 16) {
#pragma unroll
      for (int i = 0; i < 17; ++i)
#pragma unroll
        for (int j = 0; j < 4; ++j) red[(w * 17 + i) * 64 + cq * 4 + j] = acc[i][j];
    }
    __syncthreads();
    for (int e = t; e < 17 * 64; e += NTHR) {
      const int i = e >> 6, cc = e & 63;
      float s = 0.f;
#pragma unroll
      for (int ww = 0; ww < NWAVE; ++ww) s += red[(ww * 17 + i) * 64 + cc];
      mods[(size_t)(l * 17 + i) * 6144 + cb * 64 + cc] = s + p.b_ada[l * 6144 + cb * 64 + cc];
    }
  }
}

DI void transpose_tile(const float* __restrict__ src, int ldsrc, int k0, int c0, int c1, u16* __restrict__ dst, int lddst, int p0, float* tileS) {
  const int t = tid();
  __syncthreads();
  {
    const int n = (t & 15) * 4;
    const int col = (n < 32) ? (c0 + n) : (c1 + n - 32);
#pragma unroll
    for (int j = 0; j < 2; ++j) {
      const int kk = (t >> 4) + 32 * j;
      const f32x4n v = *(const f32x4n*)(src + (size_t)(k0 + kk) * ldsrc + col);
      tileS[kk * 65 + n + 0] = v.x; tileS[kk * 65 + n + 1] = v.y; tileS[kk * 65 + n + 2] = v.z; tileS[kk * 65 + n + 3] = v.w;
    }
  }
  __syncthreads();
  {
    const int kk2 = (t & 7) * 8;
    const int n2 = t >> 3;
    u32x4 o;
    o.x = pack2(tileS[(kk2 + 0) * 65 + n2], tileS[(kk2 + 1) * 65 + n2]);
    o.y = pack2(tileS[(kk2 + 2) * 65 + n2], tileS[(kk2 + 3) * 65 + n2]);
    o.z = pack2(tileS[(kk2 + 4) * 65 + n2], tileS[(kk2 + 5) * 65 + n2]);
    o.w = pack2(tileS[(kk2 + 6) * 65 + n2], tileS[(kk2 + 7) * 65 + n2]);
    *(u32x4*)(dst + (size_t)(p0 + n2) * lddst + k0 + kk2) = o;
  }
}

DI void phase0_weights(const Params& p, char* smem) {
  float* tileS = (float*)smem;
  for (int item = bid(); item < 11776; item += gridDim.x) {
    int it = item;
    if (it < 1536) {
      const int i = it / 768, r = it % 768, kt = r / 48, nt = r % 48;
      transpose_tile(p.w_in_ab + (size_t)i * 1024 * 3072, 3072, kt * 64, nt * 64, nt * 64 + 32,
                     (u16*)(p.ws + OFF_WIN_E) + (size_t)i * 3072 * 1024, 1024, nt * 64, tileS);
      continue;
    }
    it -= 1536;
    if (it < 768) {
      const int i = it / 384, r = it % 384, kt = r / 24, nt = r % 24;
      transpose_tile(p.w_in_c + (size_t)i * 1024 * 1536, 1536, kt * 64, nt * 64, nt * 64 + 32,
                     (u16*)(p.ws + OFF_WIN_O) + (size_t)i * 1536 * 1024, 1024, nt * 64, tileS);
      continue;
    }
    it -= 768;
    if (it < 1024) {
      const int l = it / 256, r = it % 256, kt = r / 16, nt = r % 16;
      const float* src = ((l & 1) ? p.w_o_c : p.w_o_ab) + (size_t)(l >> 1) * 1024 * 1024;
      transpose_tile(src, 1024, kt * 64, nt * 64, nt * 64 + 32, (u16*)(p.ws + OFF_WO) + (size_t)l * 1024 * 1024, 1024, nt * 64, tileS);
      continue;
    }
    it -= 1024;
    if (it < 5632) {
      const int l = it / 1408, r = it % 1408, kt = r / 88, pt = r % 88;
      const int ntile = pt >> 2, wn = pt & 3;
      const int c0 = ntile * 128 + wn * 32;
      transpose_tile(p.w_up + (size_t)l * 1024 * 5632, 5632, kt * 64, c0, c0 + 2816,
                     (u16*)(p.ws + OFF_WUP) + (size_t)l * 5632 * 1024, 1024, pt * 64, tileS);
      continue;
    }
    it -= 5632;
    {
      const int l = it / 704, r = it % 704, kt = r / 16, nt = r % 16;
      transpose_tile(p.w_down + (size_t)l * 2816 * 1024, 1024, kt * 64, nt * 64, nt * 64 + 32,
                     (u16*)(p.ws + OFF_WD) + (size_t)l * 1024 * 2816, 2816, nt * 64, tileS);
    }
  }
}

DI void phase0_misc(const Params& p) {
  if (bid() != 0) return;
  const int t = tid();
  f32x2n* rope = (f32x2n*)(p.ws + OFF_ROPE);
  for (int e = t; e < 1024; e += NTHR) {
    const int pos = e >> 4, f = e & 15;
    const float inv = ex2(-(float)f * 0.8304820237218406f);
    const float ang = (float)pos * inv;
    rope[e] = f32x2n{__cosf(ang), __sinf(ang)};
  }
  if (t < 2) {
    const float* lv = p.diff_lambda + t * 256;
    float s1 = 0.f, s2 = 0.f;
    for (int k = 0; k < 64; ++k) { s1 += lv[k] * lv[64 + k]; s2 += lv[128 + k] * lv[192 + k]; }
    const float li = (t == 0) ? 0.2f : 0.47071301834358393f;
    ((float*)(p.ws + OFF_LAM))[t] = __expf(s1) - __expf(s2) + li;
  }
}

DI void phase_prep(const Params& p, int l, int which) {
  const int t = tid(), lane = t & 63, w = __builtin_amdgcn_readfirstlane(t >> 6);
  const int rows = (which == 1 && l == 3) ? NLAT : NROWS;
  const bool raw = (which == 0 && l == 0);
  const float* mods = (const float*)(p.ws + OFF_MODS);
  const float* g = raw ? nullptr : (which == 0 ? p.ln_g + ((l - 1) * 2 + 1) * 1024 : p.ln_g + (l * 2) * 1024);
  const float* bb = raw ? nullptr : (which == 0 ? p.ln_b + ((l - 1) * 2 + 1) * 1024 : p.ln_b + (l * 2) * 1024);
  _Float16* X = (_Float16*)(p.ws + OFF_X);
  u16* H = (u16*)(p.ws + OFF_H);
  constexpr int NR = 2;
  const int nwv = gridDim.x * NWAVE;
  for (int Rb = bid() * NWAVE + w; Rb < rows; Rb += nwv * NR) {
    float v[NR][16];
    int RR[NR];
#pragma unroll
    for (int u = 0; u < NR; ++u) {
      const int R0 = Rb + u * nwv;
      RR[u] = R0 < rows ? R0 : Rb;
    }
    if (raw) {
#pragma unroll
      for (int u = 0; u < NR; ++u) {
        const int R = RR[u];
        const float* src = (R < NLAT) ? p.x + (size_t)R * 1024 : p.ctx + (size_t)(R - NLAT) * 1024;
#pragma unroll
        for (int q = 0; q < 2; ++q) {
          const f32x4n a = *(const f32x4n*)(src + q * 512 + lane * 8);
          const f32x4n b = *(const f32x4n*)(src + q * 512 + lane * 8 + 4);
          v[u][q * 8 + 0] = a.x; v[u][q * 8 + 1] = a.y; v[u][q * 8 + 2] = a.z; v[u][q * 8 + 3] = a.w;
          v[u][q * 8 + 4] = b.x; v[u][q * 8 + 5] = b.y; v[u][q * 8 + 6] = b.z; v[u][q * 8 + 7] = b.w;
        }
      }
    } else {
#pragma unroll
      for (int u = 0; u < NR; ++u)
#pragma unroll
        for (int q = 0; q < 2; ++q) {
          const h8 a = *(const h8*)(X + (size_t)RR[u] * 1024 + q * 512 + lane * 8);
#pragma unroll
          for (int j = 0; j < 8; ++j) v[u][q * 8 + j] = (float)a[j];
        }
      float s[NR], mean[NR], s2[NR], rstd[NR];
#pragma unroll
      for (int u = 0; u < NR; ++u) {
        s[u] = 0.f;
#pragma unroll
        for (int j = 0; j < 16; ++j) s[u] += v[u][j];
      }
#pragma unroll
      for (int o = 1; o < 64; o <<= 1)
#pragma unroll
        for (int u = 0; u < NR; ++u) s[u] += shx(s[u], lane, o);
#pragma unroll
      for (int u = 0; u < NR; ++u) {
        mean[u] = s[u] * (1.f / 1024.f);
        s2[u] = 0.f;
#pragma unroll
        for (int j = 0; j < 16; ++j) { const float d = v[u][j] - mean[u]; s2[u] += d * d; }
      }
#pragma unroll
      for (int o = 1; o < 64; o <<= 1)
#pragma unroll
        for (int u = 0; u < NR; ++u) s2[u] += shx(s2[u], lane, o);
#pragma unroll
      for (int u = 0; u < NR; ++u) rstd[u] = rsqrtf(s2[u] * (1.f / 1024.f) + EPS);
#pragma unroll
      for (int q = 0; q < 2; ++q) {
        const int c = q * 512 + lane * 8;
        const f32x4n g0 = *(const f32x4n*)(g + c), g1 = *(const f32x4n*)(g + c + 4);
        const f32x4n b0 = *(const f32x4n*)(bb + c), b1 = *(const f32x4n*)(bb + c + 4);
        const float gg[8] = {g0.x, g0.y, g0.z, g0.w, g1.x, g1.y, g1.z, g1.w};
        const float bv[8] = {b0.x, b0.y, b0.z, b0.w, b1.x, b1.y, b1.z, b1.w};
#pragma unroll
        for (int u = 0; u < NR; ++u)
#pragma unroll
          for (int j = 0; j < 8; ++j) v[u][q * 8 + j] = (v[u][q * 8 + j] - mean[u]) * rstd[u] * gg[j] + bv[j];
      }
    }
#pragma unroll
    for (int u = 0; u < NR; ++u) {
      const int R = RR[u];
      const int mi = (R < NLAT) ? (R >> 11) : 16;
      const float* md = mods + (size_t)(l * 17 + mi) * 6144 + (which == 0 ? 0 : 3 * 1024);
#pragma unroll
      for (int q = 0; q < 2; ++q) {
        const int c = q * 512 + lane * 8;
        h8 xo;
#pragma unroll
        for (int j = 0; j < 8; ++j) xo[j] = (_Float16)v[u][q * 8 + j];
        *(h8*)(X + (size_t)R * 1024 + c) = xo;
        const f32x4n s0 = *(const f32x4n*)(md + c), s1 = *(const f32x4n*)(md + c + 4);
        const f32x4n c0 = *(const f32x4n*)(md + 1024 + c), c1 = *(const f32x4n*)(md + 1024 + c + 4);
        const float sh[8] = {s0.x, s0.y, s0.z, s0.w, s1.x, s1.y, s1.z, s1.w};
        const float sc[8] = {c0.x, c0.y, c0.z, c0.w, c1.x, c1.y, c1.z, c1.w};
        float hv[8];
#pragma unroll
        for (int j = 0; j < 8; ++j) hv[j] = v[u][q * 8 + j] * (1.f + sc[j]) + sh[j];
        u32x4 o;
        o.x = pack2(hv[0], hv[1]); o.y = pack2(hv[2], hv[3]); o.z = pack2(hv[4], hv[5]); o.w = pack2(hv[6], hv[7]);
        *(u32x4*)(H + (size_t)R * 1024 + c) = o;
      }
    }
  }
}

DI void phase_final(const Params& p) {
  const int t = tid(), lane = t & 63, w = __builtin_amdgcn_readfirstlane(t >> 6);
  const float* g = p.ln_g + (3 * 2 + 1) * 1024;
  const float* bb = p.ln_b + (3 * 2 + 1) * 1024;
  const _Float16* X = (const _Float16*)(p.ws + OFF_X);
  constexpr int NR = 2;
  const int nwv = gridDim.x * NWAVE;
  for (int Rb = bid() * NWAVE + w; Rb < NLAT; Rb += nwv * NR) {
    float v[NR][16];
    int RR[NR];
#pragma unroll
    for (int u = 0; u < NR; ++u) { const int R0 = Rb + u * nwv; RR[u] = R0 < NLAT ? R0 : Rb; }
#pragma unroll
    for (int u = 0; u < NR; ++u)
#pragma unroll
      for (int q = 0; q < 2; ++q) {
        const h8 a = *(const h8*)(X + (size_t)RR[u] * 1024 + q * 512 + lane * 8);
#pragma unroll
        for (int j = 0; j < 8; ++j) v[u][q * 8 + j] = (float)a[j];
      }
    float s[NR], mean[NR], s2[NR], rstd[NR];
#pragma unroll
    for (int u = 0; u < NR; ++u) {
      s[u] = 0.f;
#pragma unroll
      for (int j = 0; j < 16; ++j) s[u] += v[u][j];
    }
#pragma unroll
    for (int o = 1; o < 64; o <<= 1)
#pragma unroll
      for (int u = 0; u < NR; ++u) s[u] += shx(s[u], lane, o);
#pragma unroll
    for (int u = 0; u < NR; ++u) {
      mean[u] = s[u] * (1.f / 1024.f);
      s2[u] = 0.f;
#pragma unroll
      for (int j = 0; j < 16; ++j) { const float d = v[u][j] - mean[u]; s2[u] += d * d; }
    }
#pragma unroll
    for (int o = 1; o < 64; o <<= 1)
#pragma unroll
      for (int u = 0; u < NR; ++u) s2[u] += shx(s2[u], lane, o);
#pragma unroll
    for (int u = 0; u < NR; ++u) rstd[u] = rsqrtf(s2[u] * (1.f / 1024.f) + EPS);
#pragma unroll
    for (int q = 0; q < 2; ++q) {
      const int c = q * 512 + lane * 8;
      const f32x4n g0 = *(const f32x4n*)(g + c), g1 = *(const f32x4n*)(g + c + 4);
      const f32x4n b0 = *(const f32x4n*)(bb + c), b1 = *(const f32x4n*)(bb + c + 4);
#pragma unroll
      for (int u = 0; u < NR; ++u) {
        f32x4n o0, o1;
        o0.x = (v[u][q * 8 + 0] - mean[u]) * rstd[u] * g0.x + b0.x; o0.y = (v[u][q * 8 + 1] - mean[u]) * rstd[u] * g0.y + b0.y;
        o0.z = (v[u][q * 8 + 2] - mean[u]) * rstd[u] * g0.z + b0.z; o0.w = (v[u][q * 8 + 3] - mean[u]) * rstd[u] * g0.w + b0.w;
        o1.x = (v[u][q * 8 + 4] - mean[u]) * rstd[u] * g1.x + b1.x; o1.y = (v[u][q * 8 + 5] - mean[u]) * rstd[u] * g1.y + b1.y;
        o1.z = (v[u][q * 8 + 6] - mean[u]) * rstd[u] * g1.z + b1.z; o1.w = (v[u][q * 8 + 7] - mean[u]) * rstd[u] * g1.w + b1.w;
        *(f32x4n*)(p.out + (size_t)RR[u] * 1024 + c) = o0;
        *(f32x4n*)(p.out + (size_t)RR[u] * 1024 + c + 4) = o1;
      }
    }
  }
}

template <int MB, class Epi>
DI void gemm_tile(const u16* __restrict__ A, int lda, int row0, int Mrows, const u16* __restrict__ Bt, int ldb, int K, char* smem, Epi& epi, int rot) {
  char* As = smem;
  char* Bs = smem + 65536;
  const unsigned lds_base = (unsigned)(size_t)(lds_char*)smem;
  const int t = tid(), lane = t & 63, w = __builtin_amdgcn_readfirstlane(t >> 6), wm = w >> 2, wn = w & 3, r = lane & 31, h = lane >> 5;
  constexpr int NAJ = MB;
  const int lr = t >> 3;
  const int lch = (t & 7) ^ ((lr >> 1) & 7);
  unsigned aoff[NAJ];
#pragma unroll
  for (int j = 0; j < NAJ; ++j) {
    int gr = row0 + lr + 64 * j;
    gr = gr < 0 ? 0 : (gr > Mrows - 1 ? Mrows - 1 : gr);
    aoff[j] = (unsigned)gr * (unsigned)lda + lch * 8;
  }
  const u16* bp = Bt + (size_t)lr * ldb + lch * 8;
  f32x16 acc[2][MB];
#pragma unroll
  for (int nb = 0; nb < 2; ++nb)
#pragma unroll
    for (int mb = 0; mb < MB; ++mb)
#pragma unroll
      for (int i = 0; i < 16; ++i) acc[nb][mb][i] = 0.f;
  const int KT = K >> 6;
  int kcur = rot % KT;
#define GEMM_PIECE(STG, PC)                                                                                           \
  {                                                                                                                   \
    if ((PC) < NAJ)                                                                                                   \
      glds16(A + ko_ + aoff[(PC) < NAJ ? (PC) : 0], lds_base + (STG) * 32768 + (w * 64 + 512 * (PC)) * 16);           \
    else if ((PC) < NAJ + 4)                                                                                          \
      glds16(bp + ko_ + (size_t)(64 * ((PC) - NAJ)) * ldb,                                                            \
             lds_base + 65536 + (STG) * 32768 + (w * 64 + 512 * ((PC) - NAJ)) * 16);                                  \
  }
#define GEMM_STAGE(STG)                                                                                               \
  {                                                                                                                   \
    const int ko_ = kcur * 64;                                                                                        \
    _Pragma("unroll") for (int pc = 0; pc < NAJ + 4; ++pc) GEMM_PIECE(STG, pc)                                        \
  }
  GEMM_STAGE(0)
  asm volatile("s_waitcnt vmcnt(0)" ::: "memory");
  __syncthreads();
  const int sw = (r >> 1) & 7;
  int foff[4];
#pragma unroll
  for (int ks = 0; ks < 4; ++ks) foff[ks] = r * 128 + (((2 * ks + h) ^ sw) << 4);
  bf8 af[2][MB], bfr[2][2];
  {
    const char* as0 = As + wm * (32 * MB) * 128;
    const char* bs0 = Bs + wn * 64 * 128;
#pragma unroll
    for (int mb = 0; mb < MB; ++mb) af[0][mb] = *(const bf8*)(as0 + mb * 32 * 128 + foff[0]);
#pragma unroll
    for (int nb = 0; nb < 2; ++nb) bfr[0][nb] = *(const bf8*)(bs0 + nb * 32 * 128 + foff[0]);
  }
  const int kbase = rot % KT;
  if (KT > 1) {
    const int k1_ = (kbase + 1 >= KT) ? kbase + 1 - KT : kbase + 1;
    const int ko_ = k1_ * 64;
#pragma unroll
    for (int pc = 0; pc < 3; ++pc) GEMM_PIECE(1, pc)
  }
  for (int kt = 0; kt < KT; ++kt) {
    const bool more = (kt + 1 < KT);
    const bool more2 = (kt + 2 < KT);
    const int nstg = (kt + 1) & 1;
    const char* as = As + (kt & 1) * 32768 + wm * (32 * MB) * 128;
    const char* bs = Bs + (kt & 1) * 32768 + wn * 64 * 128;
    int k1_ = kbase + kt + 1; if (k1_ >= KT) k1_ -= KT;
    int k2_ = kbase + kt + 2; if (k2_ >= KT) k2_ -= KT; if (k2_ >= KT) k2_ -= KT;
#pragma unroll
    for (int ks = 0; ks < 3; ++ks) {
#pragma unroll
      for (int idx = 0; idx < 2 * MB; ++idx) {
        const int nb = idx / MB, mb = idx % MB;
        acc[nb][mb] = mfma32(bfr[ks & 1][nb], af[ks & 1][mb], acc[nb][mb]);
        if (idx < MB) af[(ks + 1) & 1][idx] = *(const bf8*)(as + idx * 32 * 128 + foff[ks + 1]);
        else if (idx < MB + 2) bfr[(ks + 1) & 1][idx - MB] = *(const bf8*)(bs + (idx - MB) * 32 * 128 + foff[ks + 1]);
        if (more && ks < 2 && idx < 3) {
          const int ko_ = k1_ * 64;
          GEMM_PIECE(nstg, 3 + ks * 3 + idx)
        }
        __builtin_amdgcn_sched_barrier(0);
      }
    }
    if (more) {
      asm volatile("s_waitcnt vmcnt(0)" ::: "memory");
      __syncthreads();
      if (more2) {
        const int ko_ = k2_ * 64;
#pragma unroll
        for (int pc = 0; pc < 3; ++pc) GEMM_PIECE(kt & 1, pc)
      }
      __builtin_amdgcn_sched_barrier(0);
      const char* asn = As + nstg * 32768 + wm * (32 * MB) * 128;
      const char* bsn = Bs + nstg * 32768 + wn * 64 * 128;
#pragma unroll
      for (int mb = 0; mb < MB; ++mb) af[0][mb] = *(const bf8*)(asn + mb * 32 * 128 + foff[0]);
#pragma unroll
      for (int nb = 0; nb < 2; ++nb) bfr[0][nb] = *(const bf8*)(bsn + nb * 32 * 128 + foff[0]);
    }
#pragma unroll
    for (int nb = 0; nb < 2; ++nb)
#pragma unroll
      for (int mb = 0; mb < MB; ++mb) acc[nb][mb] = mfma32(bfr[1][nb], af[1][mb], acc[nb][mb]);
#pragma unroll
    for (int gk = 0; gk < 2 * MB; ++gk) {
      __builtin_amdgcn_sched_group_barrier(0x008, 1, 0);
      __builtin_amdgcn_sched_group_barrier(0x100, 1, 0);
    }
    __builtin_amdgcn_sched_barrier(0);
  }
  __syncthreads();
  epi(acc, wm, wn, r, h);
}

template <int MB>
struct EpiRes {
  _Float16* X; const float* gate; int row0, n0; u16* ostage;
  DI void operator()(f32x16 (&acc)[2][MB], int wm, int wn, int r, int h) {
    u16* slab = ostage + (wm * 4 + wn) * (64 * 72);
    const int lane = h * 32 + r;
#pragma unroll
    for (int mb = 0; mb < MB; ++mb) {
      const int tokl = (mb & 1) * 32 + r;
#pragma unroll
      for (int nb = 0; nb < 2; ++nb)
#pragma unroll
        for (int ig = 0; ig < 4; ++ig) {
          u32x2 o;
          o.x = pack2(acc[nb][mb][ig * 4 + 0], acc[nb][mb][ig * 4 + 1]);
          o.y = pack2(acc[nb][mb][ig * 4 + 2], acc[nb][mb][ig * 4 + 3]);
          *(u32x2*)(slab + tokl * 72 + nb * 32 + ig * 8 + h * 4) = o;
        }
      if ((mb & 1) || mb == MB - 1) {
        asm volatile("s_waitcnt lgkmcnt(0)" ::: "memory");
        const int ntok = (mb & 1) ? 64 : 32;
        const int R0 = row0 + wm * (32 * MB) + (mb >> 1) * 64;
#pragma unroll
        for (int j = 0; j < 8; ++j) {
          const int rowl = (lane >> 3) + 8 * j, ch = lane & 7;
          if (rowl < ntok) {
            const u32x4 yv = *(const u32x4*)(slab + rowl * 72 + ch * 8);
            const int R = R0 + rowl;
            const int mi = (R < NLAT) ? (R >> 11) : 16;
            const int col = n0 + wn * 64 + ch * 8;
            const float* g = gate + (size_t)mi * 6144 + col;
            const f32x4n g0 = *(const f32x4n*)(g), g1 = *(const f32x4n*)(g + 4);
            _Float16* xp = X + (size_t)R * 1024 + col;
            const h8 xv = *(const h8*)xp;
            const float y[8] = {__uint_as_float(yv.x << 16), __uint_as_float(yv.x & 0xffff0000u), __uint_as_float(yv.y << 16), __uint_as_float(yv.y & 0xffff0000u),
                                __uint_as_float(yv.z << 16), __uint_as_float(yv.z & 0xffff0000u), __uint_as_float(yv.w << 16), __uint_as_float(yv.w & 0xffff0000u)};
            const float gg[8] = {g0.x, g0.y, g0.z, g0.w, g1.x, g1.y, g1.z, g1.w};
            h8 o;
#pragma unroll
            for (int q = 0; q < 8; ++q) o[q] = (_Float16)(ALPHA * (float)xv[q] + gg[q] * y[q]);
            *(h8*)xp = o;
          }
        }
      }
    }
    __syncthreads();
  }
};

struct EpiQKV {
  int odd, row0, ntile;
  u16 *QO, *Kb, *VT;
  const f32x2n* rope;
  const float* qkn;
  u16* ostage;
  DI void operator()(f32x16 (&acc)[2][4], int wm, int wn, int r, int h) {
    const int cgi = ntile * 4 + wn;
    u16* slab = ostage + (wm * 4 + wn) * (64 * 72);
    int kind, dst, do_rope, do_norm;
    if (!odd) {
      const int seg = cgi >> 3, idx = cgi & 7;
      kind = seg % 3;
      do_rope = (seg == 3 || seg == 4);
      do_norm = 0;
      if (seg == 0) dst = idx * 64;
      else if (seg == 1) dst = idx;
      else if (seg == 2) dst = idx * 64;
      else if (seg == 3) dst = 512 + idx * 64;
      else if (seg == 4) dst = 8 + idx;
      else dst = 512 + idx * 64;
    } else {
      if (cgi < 16) { kind = 0; dst = cgi * 64; do_rope = 1; do_norm = 1; }
      else if (cgi < 20) { kind = 1; dst = cgi - 16; do_rope = 1; do_norm = 1; }
      else { kind = 2; dst = (cgi - 20) * 64; do_rope = 0; do_norm = 0; }
    }
    const int nkh = odd ? 4 : 16, nvr = odd ? 256 : 1024;
    const float* gn = qkn + (kind == 1 ? 64 : 0);
#pragma unroll
    for (int mb = 0; mb < 4; ++mb) {
      const int R = row0 + wm * 128 + mb * 32 + r;
      const bool lat = R < NLAT;
      const int b = lat ? (R >> 11) : ((R - NLAT) >> 8);
      const int tu = lat ? (R & 2047) : 2048 + ((R - NLAT) & 255);
      float v[2][16];
#pragma unroll
      for (int nb = 0; nb < 2; ++nb)
#pragma unroll
        for (int i = 0; i < 16; ++i) v[nb][i] = acc[nb][mb][i];
      if (do_norm) {
        float ss = 0.f;
#pragma unroll
        for (int nb = 0; nb < 2; ++nb)
#pragma unroll
          for (int i = 0; i < 16; ++i) ss += v[nb][i] * v[nb][i];
        ss += shx(ss, (h * 32 + r), 32);
        const float rs = rsqrtf(ss * (1.f / 64.f) + EPS);
#pragma unroll
        for (int nb = 0; nb < 2; ++nb)
#pragma unroll
          for (int ig = 0; ig < 4; ++ig) {
            const f32x4n gv = *(const f32x4n*)(gn + nb * 32 + ig * 8 + h * 4);
            v[nb][ig * 4 + 0] *= rs * gv.x; v[nb][ig * 4 + 1] *= rs * gv.y;
            v[nb][ig * 4 + 2] *= rs * gv.z; v[nb][ig * 4 + 3] *= rs * gv.w;
          }
      }
      if (do_rope && lat) {
#pragma unroll
        for (int nb = 0; nb < 2; ++nb) {
          const int pos = (nb == 0) ? (tu >> 6) : (tu & 63);
#pragma unroll
          for (int i = 0; i < 8; ++i) {
            const f32x2n cs = rope[pos * 16 + crow(i, h)];
            const float x1 = v[nb][i], x2 = v[nb][i + 8];
            v[nb][i] = x1 * cs.x - x2 * cs.y;
            v[nb][i + 8] = x2 * cs.x + x1 * cs.y;
          }
        }
      }
      const int tokl = (mb & 1) * 32 + r;
      if (kind == 2) {
#pragma unroll
        for (int nb = 0; nb < 2; ++nb)
#pragma unroll
          for (int i = 0; i < 16; ++i) slab[(nb * 32 + crow(i, h)) * 72 + tokl] = f2bf(v[nb][i]);
      } else {
#pragma unroll
        for (int nb = 0; nb < 2; ++nb)
#pragma unroll
          for (int ig = 0; ig < 4; ++ig) {
            u32x2 o;
            o.x = pack2(v[nb][ig * 4 + 0], v[nb][ig * 4 + 1]);
            o.y = pack2(v[nb][ig * 4 + 2], v[nb][ig * 4 + 3]);
            *(u32x2*)(slab + tokl * 72 + nb * 32 + ig * 8 + h * 4) = o;
          }
      }
      if (mb & 1) {
        asm volatile("s_waitcnt lgkmcnt(0)" ::: "memory");
        const int lane = h * 32 + r;
        const int R0 = row0 + wm * 128 + (mb >> 1) * 64;
        const bool lat0 = R0 < NLAT;
        const int b0 = lat0 ? (R0 >> 11) : ((R0 - NLAT) >> 8);
        const int tu0 = lat0 ? (R0 & 2047) : 2048 + ((R0 - NLAT) & 255);
#pragma unroll
        for (int j = 0; j < 8; ++j) {
          const int rowl = (lane >> 3) + 8 * j, ch = lane & 7;
          const u32x4 val = *(const u32x4*)(slab + rowl * 72 + ch * 8);
          u16* dp;
          if (kind == 2) dp = VT + ((size_t)b0 * nvr + dst + rowl) * T + tu0 + ch * 8;
          else if (kind == 0) dp = QO + (size_t)(R0 + rowl) * 1024 + dst + ch * 8;
          else dp = Kb + (((size_t)b0 * nkh + dst) * T + tu0 + rowl) * 64 + ch * 8;
          *(u32x4*)dp = val;
        }
      }
    }
    __syncthreads();
  }
};

DI float gelu_tanh(float g) {
  const float u = g * g;
  const float t = g * (-2.302208198f - 0.1029432397f * u);
  const float e = ex2(t);
  return g * __builtin_amdgcn_rcpf(1.f + e);
}

DI f32x2n gelu_tanh2(f32x2n g, f32x2n c1, f32x2n c2, f32x2n one) {
  const f32x2n u = g * g;
  const f32x2n t = g * (u * c2 + c1);
  f32x2n e = {ex2(t.x), ex2(t.y)};
  e = e + one;
  const f32x2n rr = {__builtin_amdgcn_rcpf(e.x), __builtin_amdgcn_rcpf(e.y)};
  return g * rr;
}

struct EpiUp {
  u16* act; const float* cw; const float* cb; int row0, Mrows, nt; float* edge; u16* ostage;
  DI void operator()(f32x16 (&acc)[2][4], int wm, int wn, int r, int h) {
    float* eb = edge + ((wm * 4 + wn) * 2) * 64;
    if (r == 0) {
#pragma unroll
      for (int nb = 0; nb < 2; ++nb)
#pragma unroll
        for (int i = 0; i < 16; ++i) eb[nb * 32 + crow(i, h)] = acc[nb][0][i];
    }
    if (r == 31) {
#pragma unroll
      for (int nb = 0; nb < 2; ++nb)
#pragma unroll
        for (int i = 0; i < 16; ++i) eb[64 + nb * 32 + crow(i, h)] = acc[nb][3][i];
    }
    __syncthreads();
    const float* ob = edge + (((wm ^ 1) * 4 + wn) * 2) * 64 + (wm == 0 ? 0 : 64);
    const int sp = (h << 5) | ((r - 1) & 31), sn = (h << 5) | ((r + 1) & 31);
    const int Rb = row0 + wm * 128 + r;
    u16* ost = ostage + (wm * 4 + wn) * (128 * 40);
    float kc1 = -2.302208198f, kc2 = -0.1029432397f, kone = 1.f;
    asm volatile("" : "+v"(kc1), "+v"(kc2), "+v"(kone));
    const f32x2n gc1 = {kc1, kc1}, gc2 = {kc2, kc2}, gone = {kone, kone};
    int pmi[4], nmi[4];
#pragma unroll
    for (int mb = 0; mb < 4; ++mb) {
      const int R = Rb + mb * 32;
      const bool lat = R < NLAT;
      const int tt = lat ? (R & 2047) : ((R - NLAT) & 255);
      pmi[mb] = (tt == 0) ? 0 : -1;
      nmi[mb] = (tt == (lat ? 2047 : 255)) ? 0 : -1;
    }
#pragma unroll
    for (int ig = 0; ig < 4; ++ig)
#pragma unroll
      for (int qp = 0; qp < 2; ++qp) {
        const int i0 = ig * 4 + qp * 2;
        float u[2][4][2];
        int xp[2][4], SPC[2][4], SNC[2][4];
#pragma unroll
        for (int nb = 0; nb < 2; ++nb)
#pragma unroll
          for (int mb = 0; mb < 4; ++mb) xp[nb][mb] = (int)pack2(acc[nb][mb][i0], acc[nb][mb][i0 + 1]);
#pragma unroll
        for (int nb = 0; nb < 2; ++nb)
#pragma unroll
          for (int mb = 0; mb < 4; ++mb) {
            SPC[nb][mb] = __builtin_amdgcn_ds_bpermute(sp << 2, xp[nb][mb]);
            SNC[nb][mb] = __builtin_amdgcn_ds_bpermute(sn << 2, xp[nb][mb]);
          }
        __builtin_amdgcn_sched_barrier(0);
#pragma unroll
        for (int nb = 0; nb < 2; ++nb) {
          const int eop = (int)pack2(ob[nb * 32 + crow(i0, h)], ob[nb * 32 + crow(i0 + 1, h)]);
          float w0[2], w1[2], w2[2], bz[2];
          {
            const int ff = nt * 128 + wn * 32 + crow(i0, h) + nb * DFF;
            const f32x2n a0 = *(const f32x2n*)(cw + ff), a1 = *(const f32x2n*)(cw + 2 * DFF + ff), a2 = *(const f32x2n*)(cw + 4 * DFF + ff),
                         a3 = *(const f32x2n*)(cb + ff);
            w0[0] = a0.x; w0[1] = a0.y; w1[0] = a1.x; w1[1] = a1.y; w2[0] = a2.x; w2[1] = a2.y; bz[0] = a3.x; bz[1] = a3.y;
          }
#pragma unroll
          for (int mb = 0; mb < 4; ++mb) {
            int pv = (r == 0) ? (mb > 0 ? SPC[nb][mb > 0 ? mb - 1 : 0] : eop) : SPC[nb][mb];
            int nv = (r == 31) ? (mb < 3 ? SNC[nb][mb < 3 ? mb + 1 : 3] : eop) : SNC[nb][mb];
            pv &= pmi[mb];
            nv &= nmi[mb];
            const float prev0 = __int_as_float(pv << 16), prev1 = __int_as_float(pv & 0xffff0000);
            const float next0 = __int_as_float(nv << 16), next1 = __int_as_float(nv & 0xffff0000);
            u[nb][mb][0] = w0[0] * prev0 + w1[0] * acc[nb][mb][i0] + w2[0] * next0 + bz[0];
            u[nb][mb][1] = w0[1] * prev1 + w1[1] * acc[nb][mb][i0 + 1] + w2[1] * next1 + bz[1];
          }
        }
#pragma unroll
        for (int mb = 0; mb < 4; ++mb)
        {
          const f32x2n gg = {u[1][mb][0], u[1][mb][1]}, aa = {u[0][mb][0], u[0][mb][1]};
          const f32x2n o2 = gelu_tanh2(gg, gc1, gc2, gone) * aa;
          *(unsigned*)(ost + (mb * 32 + r) * 40 + ig * 8 + h * 4 + qp * 2) = pack2(o2.x, o2.y);
        }
      }
    asm volatile("s_waitcnt lgkmcnt(0)" ::: "memory");
    const int lane = h * 32 + r;
#pragma unroll
    for (int j = 0; j < 8; ++j) {
      const int tk = (lane >> 2) + 16 * j, ch = lane & 3;
      const int tr = wm * 128 + tk;
      const int R = row0 + tr;
      const u32x4 v = *(const u32x4*)(ost + tk * 40 + ch * 8);
      if ((tr >= 1) && (tr <= 254) && (R >= 0) && (R < Mrows))
        *(u32x4*)(act + (size_t)R * DFF + nt * 128 + wn * 32 + ch * 8) = v;
    }
    __syncthreads();
  }
};

DI bool tile_map(int id, int NT, int MT, int& mt, int& nt) {
  const int x = id & 7, q = id >> 3;
  nt = q % NT;
  mt = (q / NT) * 8 + x;
  return mt < MT;
}

DI void phase_qkv(const Params& p, int l, char* smem) {
  const int odd = l & 1;
  const int NT = odd ? 6 : 12;
  const u16* W = odd ? (const u16*)(p.ws + OFF_WIN_O) + (size_t)(l >> 1) * 1536 * 1024 : (const u16*)(p.ws + OFF_WIN_E) + (size_t)(l >> 1) * 3072 * 1024;
  const u16* H = (const u16*)(p.ws + OFF_H);
  for (int tile = bid(); tile < 144 * NT; tile += gridDim.x) {
    int mt, nt;
    if (!tile_map(tile, NT, 144, mt, nt)) continue;
    EpiQKV e;
    e.odd = odd; e.row0 = mt * 256; e.ntile = nt;
    e.QO = (u16*)(p.ws + OFF_QO); e.Kb = (u16*)(p.ws + OFF_K); e.VT = (u16*)(p.ws + OFF_VT);
    e.rope = (const f32x2n*)(p.ws + OFF_ROPE);
    e.qkn = p.gqa_qk_norm + (l >> 1) * 128;
    e.ostage = (u16*)smem;
    gemm_tile<4>(H, 1024, mt * 256, NROWS, W + (size_t)nt * 256 * 1024, 1024, 1024, smem, e, tile);
  }
}

struct EpiNull {
  float* sink;
  DI void operator()(f32x16 (&acc)[2][4], int wm, int wn, int r, int h) {
    float s = 0.f;
#pragma unroll
    for (int nb = 0; nb < 2; ++nb)
#pragma unroll
      for (int mb = 0; mb < 4; ++mb)
#pragma unroll
        for (int i = 0; i < 16; ++i) s += acc[nb][mb][i];
    if (s == 123.456f) *sink = s;
  }
};
DI void phase_qkv_null(const Params& p, int l, char* smem) {
  const int odd = l & 1;
  const int NT = odd ? 6 : 12;
  const u16* W = odd ? (const u16*)(p.ws + OFF_WIN_O) + (size_t)(l >> 1) * 1536 * 1024 : (const u16*)(p.ws + OFF_WIN_E) + (size_t)(l >> 1) * 3072 * 1024;
  const u16* H = (const u16*)(p.ws + OFF_H);
  for (int tile = bid(); tile < 144 * NT; tile += gridDim.x) {
    int mt, nt;
    if (!tile_map(tile, NT, 144, mt, nt)) continue;
    EpiNull e;
    e.sink = (float*)(p.ws + OFF_LAM + 64);
    gemm_tile<4>(H, 1024, mt * 256, NROWS, W + (size_t)nt * 256 * 1024, 1024, 1024, smem, e, tile);
  }
}

template <int MB>
DI void phase_res_t(const Params& p, int l, int which, char* smem) {
  constexpr int TR = 64 * MB;
  const int rows = (l == 3) ? NLAT : NROWS;
  const int MT = rows / TR;
  const u16* A = which ? (const u16*)(p.ws + OFF_ACT) : (const u16*)(p.ws + OFF_QO);
  const int lda = which ? DFF : 1024, K = which ? DFF : 1024;
  const u16* W = which ? (const u16*)(p.ws + OFF_WD) + (size_t)l * 1024 * DFF : (const u16*)(p.ws + OFF_WO) + (size_t)l * 1024 * 1024;
  const float* gate = (const float*)(p.ws + OFF_MODS) + (size_t)l * 17 * 6144 + (which ? 5 : 2) * 1024;
  for (int tile = bid(); tile < MT * 4; tile += gridDim.x) {
    int mt, nt;
    if (!tile_map(tile, 4, MT, mt, nt)) continue;
    EpiRes<MB> e;
    e.X = (_Float16*)(p.ws + OFF_X); e.gate = gate; e.row0 = mt * TR; e.n0 = nt * 256; e.ostage = (u16*)smem;
    gemm_tile<MB>(A, lda, mt * TR, rows, W + (size_t)nt * 256 * K, K, K, smem, e, tile);
  }
}
DI void phase_res(const Params& p, int l, int which, char* smem) {
  if (l == 3) phase_res_t<4>(p, l, which, smem);
  else phase_res_t<3>(p, l, which, smem);
}

DI void phase_up(const Params& p, int l, char* smem) {
  const int rows = (l == 3) ? NLAT : NROWS;
  const int MT = (rows + 253) / 254;
  const int MTP = (MT + 7) & ~7;
  const u16* W = (const u16*)(p.ws + OFF_WUP) + (size_t)l * 5632 * 1024;
  const u16* H = (const u16*)(p.ws + OFF_H);
  for (int tile = bid(); tile < MT * 22; tile += gridDim.x) {
    const int mt = tile / 22, nt = tile - mt * 22;
    EpiUp e;
    e.act = (u16*)(p.ws + OFF_ACT); e.cw = p.conv_w + (size_t)l * 3 * 5632; e.cb = p.conv_b + (size_t)l * 5632;
    e.row0 = mt * 254 - 1; e.Mrows = rows; e.nt = nt; e.edge = (float*)(smem + 131072); e.ostage = (u16*)smem;
    gemm_tile<4>(H, 1024, mt * 254 - 1, rows, W + (size_t)nt * 256 * 1024, 1024, 1024, smem, e, tile);
  }
}

struct AttnArgs {
  u16* qo;
  const u16 *k1, *k2, *vt;
  int s0, n0, n1;
  const float* rpb;
  int rq0, us;
  float lam, oml;
  const float* subln;
};

template <int DV, int MODE>
DI void attn_item(const AttnArgs& a, char* smem) {
  u16* Ks1 = (u16*)smem;
  u16* Ks2 = (u16*)(smem + 9216);
  u16* Vs = (u16*)(smem + 18432);
  float* rpbS = (float*)(smem + 36864);
  const int t = tid(), lane = t & 63, w = __builtin_amdgcn_readfirstlane(t >> 6), r = lane & 31, h = lane >> 5;
  constexpr int NDV = DV / 32;
  constexpr int NVL = DV / 64;
  const int nt = a.n0 + a.n1;

  const int qrow = (MODE == 1) ? ((w & 3) * 32 + r) : (w * 32 + r);
  const int qcoff = (MODE == 1) ? ((w >> 2) * 64) : 0;
  u16* qp = a.qo + (size_t)qrow * 1024;
  bf8 qf[4];
#pragma unroll
  for (int ks = 0; ks < 4; ++ks) qf[ks] = *(const bf8*)(qp + qcoff + ks * 16 + h * 8);
  const u16* Ks = (MODE == 1 && (w >> 2)) ? Ks2 : Ks1;

  int rq = 0, qc = 0, cs = 0, rsw = 0;
  if (MODE == 2) {
    __syncthreads();
    for (int e = t; e < 15 * 32; e += NTHR) {
      const int dr = e >> 5, dc = e & 31;
      rpbS[e] = (dc < 31) ? a.rpb[dr * 31 + dc] * LOG2E : 0.f;
    }
    rq = a.rq0 + (w >> 1);
    qc = (w & 1) * 32 + r;
    cs = qc - 8; cs = cs < 0 ? 0 : (cs > 48 ? 48 : cs);
    rsw = rq - 4; rsw = rsw < 0 ? 0 : (rsw > 24 ? 24 : rsw);
  }

  f32x16 O[NDV];
#pragma unroll
  for (int d = 0; d < NDV; ++d)
#pragma unroll
    for (int i = 0; i < 16; ++i) O[d][i] = 0.f;
  float m = -1e30f, lsum = 0.f;

  u32x4 rk1, rk2, rv[NVL];
  const int srow = t >> 3, sch = t & 7;
#define ATTN_FETCH(TT)                                                                                         \
  {                                                                                                            \
    const int tt_ = (TT);                                                                                      \
    const int key0_ = tt_ < a.n0 ? a.s0 + tt_ * 64 : 2048 + (tt_ - a.n0) * 64;                                 \
    rk1 = *(const u32x4*)(a.k1 + (size_t)(key0_ + srow) * 64 + sch * 8);                                       \
    if (MODE == 1) rk2 = *(const u32x4*)(a.k2 + (size_t)(key0_ + srow) * 64 + sch * 8);                        \
    _Pragma("unroll") for (int j = 0; j < NVL; ++j)                                                            \
        rv[j] = *(const u32x4*)(a.vt + (size_t)(srow + 64 * j) * T + key0_ + sch * 8);                         \
  }
  if (nt > 0) ATTN_FETCH(0)
  for (int tt = 0; tt < nt; ++tt) {
    __syncthreads();
    *(u32x4*)(Ks1 + srow * 72 + sch * 8) = rk1;
    if (MODE == 1) *(u32x4*)(Ks2 + srow * 72 + sch * 8) = rk2;
#pragma unroll
    for (int j = 0; j < NVL; ++j) *(u32x4*)(Vs + (srow + 64 * j) * 72 + sch * 8) = rv[j];
    __syncthreads();
    if (tt + 1 < nt) ATTN_FETCH(tt + 1)
    __builtin_amdgcn_sched_barrier(0);

    bool active = true;
    int kr = 0;
    const bool local = (MODE == 2) && (tt < a.n0);
    if (local) { kr = a.us + tt; active = (kr >= rsw) && (kr < rsw + 8); }
    if (active) {
      f32x16 s[2];
#pragma unroll
      for (int kb = 0; kb < 2; ++kb) {
#pragma unroll
        for (int i = 0; i < 16; ++i) s[kb][i] = 0.f;
#pragma unroll
        for (int ks = 0; ks < 4; ++ks) {
          const bf8 kf = *(const bf8*)(Ks + (kb * 32 + r) * 72 + ks * 16 + h * 8);
          s[kb] = mfma32(kf, qf[ks], s[kb]);
        }
      }
      constexpr float SC = 0.125f * LOG2E;
      float mx = -INFINITY;
      if (local) {
#pragma unroll
        for (int kb = 0; kb < 2; ++kb)
#pragma unroll
          for (int i = 0; i < 16; ++i) {
            const int kc = kb * 32 + crow(i, h);
            const bool ok = (kc >= cs) && (kc < cs + 16);
            const int dc = kc - qc + 15;
            const int dr = kr - rq + 7;
            const float bias = rpbS[dr * 32 + (ok ? dc : 0)];
            const float v = ok ? (s[kb][i] + bias * (1.f / SC)) : -INFINITY;
            s[kb][i] = v;
            mx = fmaxf(mx, v);
          }
      } else {
#pragma unroll
        for (int kb = 0; kb < 2; ++kb)
#pragma unroll
          for (int i = 0; i < 16; i += 2) mx = fmaxf(fmaxf(mx, s[kb][i]), s[kb][i + 1]);
      }
      mx = fmaxf(mx, shx(mx, lane, 32)) * SC;
      const float mn = fmaxf(m, mx);
      const bool resc = __builtin_amdgcn_ballot_w64(mn != m) != 0ull;
      float ps0 = 0.f, ps1 = 0.f;
#pragma unroll
      for (int kb = 0; kb < 2; ++kb)
#pragma unroll
        for (int i = 0; i < 16; i += 2) {
          f32x2n v = {s[kb][i], s[kb][i + 1]};
          v = v * f32x2n{SC, SC} - f32x2n{mn, mn};
          const float p0 = ex2(v.x), p1 = ex2(v.y);
          s[kb][i] = p0; s[kb][i + 1] = p1;
          ps0 += p0; ps1 += p1;
        }
      if (resc) {
        const float alpha = ex2(m - mn);
        m = mn;
        lsum *= alpha;
#pragma unroll
        for (int d = 0; d < NDV; ++d)
#pragma unroll
          for (int i = 0; i < 16; ++i) O[d][i] *= alpha;
      }
      lsum += ps0 + ps1;
#pragma unroll
      for (int kb = 0; kb < 2; ++kb)
#pragma unroll
        for (int s2 = 0; s2 < 2; ++s2) {
          u32x4 pk;
          pk.x = pack2(s[kb][s2 * 8 + 0], s[kb][s2 * 8 + 1]);
          pk.y = pack2(s[kb][s2 * 8 + 2], s[kb][s2 * 8 + 3]);
          pk.z = pack2(s[kb][s2 * 8 + 4], s[kb][s2 * 8 + 5]);
          pk.w = pack2(s[kb][s2 * 8 + 6], s[kb][s2 * 8 + 7]);
          const bf8 pf = __builtin_bit_cast(bf8, pk);
#pragma unroll
          for (int d = 0; d < NDV; ++d) {
            const u16* vp = Vs + (d * 32 + r) * 72 + kb * 32 + s2 * 16 + 4 * h;
            u32x4 vv;
            const u32x2 lo = *(const u32x2*)(vp);
            const u32x2 hi = *(const u32x2*)(vp + 8);
            vv.x = lo.x; vv.y = lo.y; vv.z = hi.x; vv.w = hi.y;
            O[d] = mfma32(__builtin_bit_cast(bf8, vv), pf, O[d]);
          }
        }
    }
  }
  const float ltot = lsum + shx(lsum, lane, 32);
  const float inv = 1.f / ltot;
  if (MODE != 1) {
#pragma unroll
    for (int d = 0; d < NDV; ++d)
#pragma unroll
      for (int ig = 0; ig < 4; ++ig) {
        u32x2 o;
        o.x = pack2(O[d][ig * 4 + 0] * inv, O[d][ig * 4 + 1] * inv);
        o.y = pack2(O[d][ig * 4 + 2] * inv, O[d][ig * 4 + 3] * inv);
        *(u32x2*)(qp + d * 32 + ig * 8 + h * 4) = o;
      }
  } else {
    float* comb = (float*)smem;
    __syncthreads();
    if (w >= 4) {
#pragma unroll
      for (int d = 0; d < NDV; ++d)
#pragma unroll
        for (int i = 0; i < 16; ++i) comb[((w - 4) * 128 + d * 32 + crow(i, h)) * 32 + r] = O[d][i] * inv;
    }
    __syncthreads();
    if (w < 4) {
      float ss = 0.f;
#pragma unroll
      for (int d = 0; d < NDV; ++d)
#pragma unroll
        for (int i = 0; i < 16; ++i) {
          const float o = O[d][i] * inv - a.lam * comb[(w * 128 + d * 32 + crow(i, h)) * 32 + r];
          O[d][i] = o;
          ss += o * o;
        }
      ss += shx(ss, lane, 32);
      const float rs = rsqrtf(ss * (1.f / 128.f) + EPS) * a.oml;
#pragma unroll
      for (int d = 0; d < NDV; ++d)
#pragma unroll
        for (int ig = 0; ig < 4; ++ig) {
          const f32x4n gv = *(const f32x4n*)(a.subln + d * 32 + ig * 8 + h * 4);
          u32x2 o;
          o.x = pack2(O[d][ig * 4 + 0] * rs * gv.x, O[d][ig * 4 + 1] * rs * gv.y);
          o.y = pack2(O[d][ig * 4 + 2] * rs * gv.z, O[d][ig * 4 + 3] * rs * gv.w);
          *(u32x2*)(qp + d * 32 + ig * 8 + h * 4) = o;
        }
    }
  }
}

DI void attn_item_q64(const AttnArgs& a, char* smem) {
  char* Kb_ = smem;
  char* Vb_ = smem + 16384;
  const unsigned lds_base = (unsigned)(size_t)(lds_char*)smem;
  const int t = tid(), lane = t & 63, w = __builtin_amdgcn_readfirstlane(t >> 6), r = lane & 31, h = lane >> 5;
  const int nt = a.n0 + a.n1;
  u16* qp[2];
  bf8 qf[2][4];
#pragma unroll
  for (int q2 = 0; q2 < 2; ++q2) {
    qp[q2] = a.qo + (size_t)(w * 64 + q2 * 32 + r) * 1024;
#pragma unroll
    for (int ks = 0; ks < 4; ++ks) qf[q2][ks] = *(const bf8*)(qp[q2] + ks * 16 + h * 8);
  }
  f32x16 O[2][2];
#pragma unroll
  for (int q2 = 0; q2 < 2; ++q2)
#pragma unroll
    for (int d = 0; d < 2; ++d)
#pragma unroll
      for (int i = 0; i < 16; ++i) O[q2][d][i] = 0.f;
  float m[2] = {-1e30f, -1e30f}, lsum[2] = {0.f, 0.f};
  const int srow = t >> 3, sch = (t & 7) ^ ((srow >> 1) & 7);
  const u16* kg = a.k1 + (size_t)srow * 64 + sch * 8;
  const u16* vg = a.vt + (size_t)srow * T + sch * 8;
#define ATTN2_ISSUE(TT, BUF)                                                                                   \
  {                                                                                                            \
    const int tt_ = (TT) < nt ? (TT) : nt - 1;                                                                 \
    const int key0_ = tt_ < a.n0 ? a.s0 + tt_ * 64 : 2048 + (tt_ - a.n0) * 64;                                 \
    glds16(kg + (size_t)key0_ * 64, lds_base + (BUF) * 8192 + w * 1024);                                       \
    glds16(vg + key0_, lds_base + 16384 + (BUF) * 8192 + w * 1024);                                            \
  }
  __syncthreads();
  ATTN2_ISSUE(0, 0)
  ATTN2_ISSUE(1, 1)
  asm volatile("s_waitcnt vmcnt(2)" ::: "memory");
  __syncthreads();
  const int sw = (r >> 1) & 7;
  int koff[4];
#pragma unroll
  for (int ks = 0; ks < 4; ++ks) koff[ks] = r * 128 + (((2 * ks + h) ^ sw) << 4);
  for (int tt = 0; tt < nt; ++tt) {
    const char* Ks = Kb_ + (tt & 1) * 8192;
    const char* Vs = Vb_ + (tt & 1) * 8192;
    f32x16 s[2][2];
#pragma unroll
    for (int kb = 0; kb < 2; ++kb) {
#pragma unroll
      for (int q2 = 0; q2 < 2; ++q2)
#pragma unroll
        for (int i = 0; i < 16; ++i) s[q2][kb][i] = 0.f;
#pragma unroll
      for (int ks = 0; ks < 4; ++ks) {
        const bf8 kf = *(const bf8*)(Ks + kb * 32 * 128 + koff[ks]);
#pragma unroll
        for (int q2 = 0; q2 < 2; ++q2) s[q2][kb] = mfma32(kf, qf[q2][ks], s[q2][kb]);
      }
    }
    constexpr float SC = 0.125f * LOG2E;
#pragma unroll
    for (int q2 = 0; q2 < 2; ++q2) {
      float mx = -INFINITY;
#pragma unroll
      for (int kb = 0; kb < 2; ++kb)
#pragma unroll
        for (int i = 0; i < 16; i += 2) mx = fmaxf(fmaxf(mx, s[q2][kb][i]), s[q2][kb][i + 1]);
      mx = fmaxf(mx, shx(mx, lane, 32)) * SC;
      const float mn = fmaxf(m[q2], mx);
      const bool resc = __builtin_amdgcn_ballot_w64(mn != m[q2]) != 0ull;
      float ps0 = 0.f, ps1 = 0.f;
#pragma unroll
      for (int kb = 0; kb < 2; ++kb)
#pragma unroll
        for (int i = 0; i < 16; i += 2) {
          f32x2n v = {s[q2][kb][i], s[q2][kb][i + 1]};
          v = v * f32x2n{SC, SC} - f32x2n{mn, mn};
          const float p0 = ex2(v.x), p1 = ex2(v.y);
          s[q2][kb][i] = p0; s[q2][kb][i + 1] = p1;
          ps0 += p0; ps1 += p1;
        }
      if (resc) {
        const float alpha = ex2(m[q2] - mn);
        m[q2] = mn;
        lsum[q2] *= alpha;
#pragma unroll
        for (int d = 0; d < 2; ++d)
#pragma unroll
          for (int i = 0; i < 16; ++i) O[q2][d][i] *= alpha;
      }
      lsum[q2] += ps0 + ps1;
    }
#pragma unroll
    for (int kb = 0; kb < 2; ++kb)
#pragma unroll
      for (int s2 = 0; s2 < 2; ++s2) {
        const int kk = kb * 2 + s2;
        bf8 pf[2];
#pragma unroll
        for (int q2 = 0; q2 < 2; ++q2) {
          u32x4 pk;
          pk.x = pack2(s[q2][kb][s2 * 8 + 0], s[q2][kb][s2 * 8 + 1]);
          pk.y = pack2(s[q2][kb][s2 * 8 + 2], s[q2][kb][s2 * 8 + 3]);
          pk.z = pack2(s[q2][kb][s2 * 8 + 4], s[q2][kb][s2 * 8 + 5]);
          pk.w = pack2(s[q2][kb][s2 * 8 + 6], s[q2][kb][s2 * 8 + 7]);
          pf[q2] = __builtin_bit_cast(bf8, pk);
        }
#pragma unroll
        for (int d = 0; d < 2; ++d) {
          const char* vrow = Vs + (d * 32 + r) * 128 + 8 * h;
          u32x4 vv;
          const u32x2 lo = *(const u32x2*)(vrow + (((2 * kk) ^ sw) << 4));
          const u32x2 hi = *(const u32x2*)(vrow + (((2 * kk + 1) ^ sw) << 4));
          vv.x = lo.x; vv.y = lo.y; vv.z = hi.x; vv.w = hi.y;
          const bf8 vf = __builtin_bit_cast(bf8, vv);
#pragma unroll
          for (int q2 = 0; q2 < 2; ++q2) O[q2][d] = mfma32(vf, pf[q2], O[q2][d]);
        }
      }
    asm volatile("s_waitcnt vmcnt(0)" ::: "memory");
    __syncthreads();
    if (tt + 2 < nt) ATTN2_ISSUE(tt + 2, tt & 1)
  }
#pragma unroll
  for (int q2 = 0; q2 < 2; ++q2) {
    const float ltot = lsum[q2] + shx(lsum[q2], lane, 32);
    const float inv = 1.f / ltot;
#pragma unroll
    for (int d = 0; d < 2; ++d)
#pragma unroll
      for (int ig = 0; ig < 4; ++ig) {
        u32x2 o;
        o.x = pack2(O[q2][d][ig * 4 + 0] * inv, O[q2][d][ig * 4 + 1] * inv);
        o.y = pack2(O[q2][d][ig * 4 + 2] * inv, O[q2][d][ig * 4 + 3] * inv);
        *(u32x2*)(qp[q2] + d * 32 + ig * 8 + h * 4) = o;
      }
  }
}

DI void phase_attn(const Params& p, int l, char* smem) {
  u16* QO = (u16*)(p.ws + OFF_QO);
  const u16* Kb = (const u16*)(p.ws + OFF_K);
  const u16* VT = (const u16*)(p.ws + OFF_VT);
  const bool need_ctx = l < 3;
  if (l & 1) {
    const int total = 1024 + (need_ctx ? 256 : 0);
    for (int id = bid(); id < total; id += gridDim.x) {
      AttnArgs a;
      a.k2 = nullptr; a.rpb = nullptr; a.rq0 = 0; a.us = 0; a.lam = 0.f; a.oml = 0.f; a.subln = nullptr;
      if (id < 1024) {
        const int x = id & 7, q = id >> 3, within = q & 15, g = (q >> 4) * 8 + x;
        const int b = g >> 2, kvh = g & 3, hq = kvh * 4 + (within >> 2), qb = within & 3;
        a.qo = QO + (size_t)(b * 2048 + qb * 512) * 1024 + hq * 64;
        a.k1 = Kb + ((size_t)b * 4 + kvh) * T * 64;
        a.vt = VT + ((size_t)b * 256 + kvh * 64) * T;
        a.s0 = 0; a.n0 = 32; a.n1 = 4;
        attn_item_q64(a, smem);
        continue;
      } else {
        const int id2 = id - 1024;
        const int hq = id2 & 15, b = id2 >> 4, kvh = hq >> 2;
        a.qo = QO + (size_t)(NLAT + b * 256) * 1024 + hq * 64;
        a.k1 = Kb + ((size_t)b * 4 + kvh) * T * 64;
        a.vt = VT + ((size_t)b * 256 + kvh * 64) * T;
        a.s0 = 0; a.n0 = 0; a.n1 = 4;
      }
      attn_item<64, 0>(a, smem);
    }
  } else {
    const int li = l >> 1;
    const float lam = ((const float*)(p.ws + OFF_LAM))[li];
    const float oml = 1.f - ((li == 0) ? 0.2f : 0.47071301834358393f);
    const int total = 1024 + 1024 + (need_ctx ? 128 + 128 : 0);
    for (int id = bid(); id < total; id += gridDim.x) {
      AttnArgs a;
      a.k2 = nullptr; a.rpb = nullptr; a.rq0 = 0; a.us = 0; a.lam = lam; a.oml = oml; a.subln = p.diff_subln + li * 128;
      if (id < 1024) {
        const int x = id & 7, q = id >> 3, qb = q & 15, g = (q >> 4) * 8 + x;
        const int b = g >> 2, j = g & 3;
        a.qo = QO + (size_t)(b * 2048 + qb * 128) * 1024 + 512 + j * 128;
        a.k1 = Kb + ((size_t)b * 16 + 8 + 2 * j) * T * 64;
        a.k2 = Kb + ((size_t)b * 16 + 8 + 2 * j + 1) * T * 64;
        a.vt = VT + ((size_t)b * 1024 + 512 + j * 128) * T;
        a.s0 = 0; a.n0 = 32; a.n1 = 4;
        attn_item<128, 1>(a, smem);
      } else if (id < 2048) {
        const int id2 = id - 1024;
        const int x = id2 & 7, q = id2 >> 3, pr = q & 7, g = (q >> 3) * 8 + x;
        const int b = g >> 3, hd = g & 7;
        const int r0 = 4 * pr;
        int rs0 = r0 - 4; rs0 = rs0 < 0 ? 0 : (rs0 > 24 ? 24 : rs0);
        int rs3 = r0 - 1; rs3 = rs3 < 0 ? 0 : (rs3 > 24 ? 24 : rs3);
        a.qo = QO + (size_t)(b * 2048 + r0 * 64) * 1024 + hd * 64;
        a.k1 = Kb + ((size_t)b * 16 + hd) * T * 64;
        a.vt = VT + ((size_t)b * 1024 + hd * 64) * T;
        a.s0 = rs0 * 64; a.n0 = rs3 + 8 - rs0; a.n1 = 4;
        a.rpb = p.na_rpb + ((size_t)li * 8 + hd) * 15 * 31;
        a.rq0 = r0; a.us = rs0;
        attn_item<64, 2>(a, smem);
      } else if (id < 2048 + 128) {
        const int g = id - 2048, b = g >> 3, hd = g & 7;
        a.qo = QO + (size_t)(NLAT + b * 256) * 1024 + hd * 64;
        a.k1 = Kb + ((size_t)b * 16 + hd) * T * 64;
        a.vt = VT + ((size_t)b * 1024 + hd * 64) * T;
        a.s0 = 0; a.n0 = 0; a.n1 = 4;
        attn_item<64, 0>(a, smem);
      } else {
        const int id2 = id - 2048 - 128;
        const int qb = id2 & 1, g = id2 >> 1, b = g >> 2, j = g & 3;
        a.qo = QO + (size_t)(NLAT + b * 256 + qb * 128) * 1024 + 512 + j * 128;
        a.k1 = Kb + ((size_t)b * 16 + 8 + 2 * j) * T * 64;
        a.k2 = Kb + ((size_t)b * 16 + 8 + 2 * j + 1) * T * 64;
        a.vt = VT + ((size_t)b * 1024 + 512 + j * 128) * T;
        a.s0 = 0; a.n0 = 0; a.n1 = 4;
        attn_item<128, 1>(a, smem);
      }
    }
  }
}

constexpr int N_PHASES = 30;
DI void run_phase(const Params& p, int ph, char* smem) {
  if (ph == 0) {
    phase0_mods(p, smem);
    phase0_weights(p, smem);
    phase0_misc(p);
    return;
  }
  if (ph == 29) { phase_final(p); return; }
  const int l = (ph - 1) / 7, s = (ph - 1) % 7;
  switch (s) {
    case 0: phase_prep(p, l, 0); break;
    case 1: phase_qkv(p, l, smem); break;
    case 2: phase_attn(p, l, smem); break;
    case 3: phase_res(p, l, 0, smem); break;
    case 4: phase_prep(p, l, 1); break;
    case 5: phase_up(p, l, smem); break;
    default: phase_res(p, l, 1, smem); break;
  }
}

#if MK_MULTI
__global__ void __launch_bounds__(512, 2) fwd_megakernel(Params p, int ph_lo, int ph_hi) {
  __shared__ __attribute__((aligned(16))) char smem[SMEM_BYTES];
  for (int ph = ph_lo; ph < ph_hi; ++ph) run_phase(p, ph, smem);
}
#else
#if USE_XCD_BARRIER
#define GRID_BARRIER() xcd_barrier(xb)
#else
#define GRID_BARRIER() grid.sync()
#endif
__global__ void __launch_bounds__(512, 2) fwd_megakernel(Params p, int ph_lo, int ph_hi) {
  __shared__ __attribute__((aligned(16))) char smem[SMEM_BYTES];
  __shared__ __attribute__((aligned(16))) unsigned xb_words[4];
  cg::grid_group grid = cg::this_grid();
  if (threadIdx.x < 4) xb_words[threadIdx.x] = 0u;
  __syncthreads();
  const XcdBarrier xb = xcd_barrier_post((unsigned*)(p.ws + OFF_BAR), (volatile LAS unsigned*)xb_words);
  phase0_mods(p, smem);
  phase0_weights(p, smem);
  phase0_misc(p);
  grid.sync();
#pragma unroll 1
  for (int l = 0; l < 4; ++l) {
    phase_prep(p, l, 0);
    GRID_BARRIER();
#if PROBE == 1
    phase_qkv(p, l, smem);
    GRID_BARRIER();
    phase_attn(p, l, smem);
    GRID_BARRIER();
#endif
#if PROBE == 2
    phase_qkv(p, l, smem);
    GRID_BARRIER();
#endif
#if PROBE == 4
    phase_qkv_null(p, l, smem);
    GRID_BARRIER();
#endif
#if PROBE == 5
    GRID_BARRIER(); GRID_BARRIER(); GRID_BARRIER(); GRID_BARRIER(); GRID_BARRIER(); GRID_BARRIER(); GRID_BARRIER();
#endif
    phase_qkv(p, l, smem);
    GRID_BARRIER();
    phase_attn(p, l, smem);
    GRID_BARRIER();
    phase_res(p, l, 0, smem);
    GRID_BARRIER();
    phase_prep(p, l, 1);
    GRID_BARRIER();
#if PROBE == 3
    phase_up(p, l, smem);
    GRID_BARRIER();
#endif
    phase_up(p, l, smem);
    GRID_BARRIER();
    phase_res(p, l, 1, smem);
    GRID_BARRIER();
  }
  phase_final(p);
}
#endif

extern "C" void kernel_launch(void* const* d_in, const int* in_sizes, int n_in, void* d_out, int out_size, void* d_ws, size_t ws_size,
                              hipStream_t stream) {
  static int grid_blocks = 0;
  if (!grid_blocks) {
    int dev = 0, cus = 0, per_cu = 0;
    hipGetDevice(&dev);
    hipDeviceGetAttribute(&cus, hipDeviceAttributeMultiprocessorCount, dev);
    hipOccupancyMaxActiveBlocksPerMultiprocessor(&per_cu, fwd_megakernel, NTHR, 0);
    per_cu = 1;
    grid_blocks = cus * per_cu;
  }
  if (ws_size < WS_NEEDED) fprintf(stderr, "workspace too small: %zu < %zu\n", ws_size, (size_t)WS_NEEDED);
  Params p{};
  p.x = (const float*)d_in[0]; p.c = (const float*)d_in[1]; p.ctx = (const float*)d_in[2]; p.c_ctx = (const float*)d_in[3];
  p.w_ada = (const float*)d_in[4]; p.b_ada = (const float*)d_in[5]; p.ln_g = (const float*)d_in[6]; p.ln_b = (const float*)d_in[7];
  p.w_in_ab = (const float*)d_in[8]; p.w_o_ab = (const float*)d_in[9]; p.na_rpb = (const float*)d_in[10];
  p.diff_lambda = (const float*)d_in[11]; p.diff_subln = (const float*)d_in[12]; p.w_in_c = (const float*)d_in[13];
  p.w_o_c = (const float*)d_in[14]; p.gqa_qk_norm = (const float*)d_in[15]; p.w_up = (const float*)d_in[16];
  p.conv_w = (const float*)d_in[17]; p.conv_b = (const float*)d_in[18]; p.w_down = (const float*)d_in[19];
  p.out = (float*)d_out;
  p.ws = (char*)d_ws;
  hipMemsetAsync((char*)d_ws + OFF_BAR, 0, 16384, stream);
#if MK_MULTI
  for (int ph = 0; ph < N_PHASES; ++ph) {
    hipLaunchKernelGGL(fwd_megakernel, dim3(grid_blocks), dim3(NTHR), 0, stream, p, ph, ph + 1);
  }
#else
  int lo = 0, hi = N_PHASES;
  void* args[] = {&p, &lo, &hi};
  hipError_t e = hipLaunchCooperativeKernel((void*)fwd_megakernel, dim3(grid_blocks), dim3(NTHR), args, 0, stream);
  if (e != hipSuccess) fprintf(stderr, "cooperative launch failed: %s (grid %d)\n", hipGetErrorString(e), grid_blocks);
#endif
}
```

```cpp
#include <hip/hip_runtime.h>
#include <hip/hip_cooperative_groups.h>
#include <cstdio>
namespace cg = cooperative_groups;

#ifndef PROBE
#define PROBE 0
#endif
#ifndef USE_XCD_BARRIER
#define USE_XCD_BARRIER 1
#endif
#ifndef MK_MULTI
#define MK_MULTI 0
#endif

#define DI __device__ __forceinline__
typedef unsigned short u16;
typedef __attribute__((ext_vector_type(8))) __bf16 bf8;
typedef __attribute__((ext_vector_type(2))) __bf16 bf2;
typedef __attribute__((ext_vector_type(2))) float f2;
typedef __attribute__((ext_vector_type(16))) float f32x16;
typedef __attribute__((ext_vector_type(4))) _Float16 h4;
typedef __attribute__((ext_vector_type(8))) _Float16 h8;
typedef __attribute__((ext_vector_type(4))) unsigned u32x4;
typedef __attribute__((ext_vector_type(2))) unsigned u32x2;
typedef __attribute__((ext_vector_type(4))) float f32x4n;
typedef __attribute__((ext_vector_type(2))) float f32x2n;

constexpr int NLAT = 32768, NCTX = 4096, NROWS = 36864, T = 2304, DFF = 2816;
constexpr float ALPHA = 1.681792830507429f;
constexpr float EPS = 1e-6f;
constexpr float LOG2E = 1.4426950408889634f;

constexpr size_t OFF_MODS = 0;
constexpr size_t OFF_ROPE = OFF_MODS + 1671168;
constexpr size_t OFF_LAM = OFF_ROPE + 8192;
constexpr size_t OFF_WIN_E = OFF_LAM + 256;
constexpr size_t OFF_WIN_O = OFF_WIN_E + 12582912;
constexpr size_t OFF_WO = OFF_WIN_O + 6291456;
constexpr size_t OFF_WUP = OFF_WO + 8388608;
constexpr size_t OFF_WD = OFF_WUP + 46137344;
constexpr size_t OFF_X = OFF_WD + 23068672;
constexpr size_t OFF_H = OFF_X + 75497472;
constexpr size_t OFF_QO = OFF_H + 75497472;
constexpr size_t OFF_K = OFF_QO + 75497472;
constexpr size_t OFF_VT = OFF_K + 75497472;
constexpr size_t OFF_END = OFF_VT + 75497472;
constexpr size_t OFF_ACT = OFF_QO;
constexpr size_t OFF_BAR = OFF_END;
constexpr size_t WS_NEEDED = OFF_BAR + 16384;

constexpr int SMEM_BYTES = 131072 + 4096;
constexpr int NTHR = 512, NWAVE = 8;

struct Params {
  const float *x, *c, *ctx, *c_ctx, *w_ada, *b_ada, *ln_g, *ln_b, *w_in_ab, *w_o_ab, *na_rpb, *diff_lambda, *diff_subln,
      *w_in_c, *w_o_c, *gqa_qk_norm, *w_up, *conv_w, *conv_b, *w_down;
  float* out;
  char* ws;
};

DI unsigned pack2(float a, float b) { f2 v = {a, b}; bf2 r = __builtin_convertvector(v, bf2); return __builtin_bit_cast(unsigned, r); }
DI u16 f2bf(float a) { __bf16 b = (__bf16)a; return __builtin_bit_cast(u16, b); }
DI int crow(int i, int h) { return (i & 3) + 8 * (i >> 2) + 4 * h; }
DI f32x16 mfma32(bf8 a, bf8 b, f32x16 c) { return __builtin_amdgcn_mfma_f32_32x32x16_bf16(a, b, c, 0, 0, 0); }
DI int tid() { int t; asm volatile("v_mov_b32 %0, %1" : "=v"(t) : "v"((int)threadIdx.x)); return t; }
DI int bid() { int b; asm volatile("s_mov_b32 %0, %1" : "=s"(b) : "s"((int)blockIdx.x)); return b; }
typedef __attribute__((address_space(3))) char lds_char;
DI void glds16(const void* gptr, unsigned lds_addr) {
  asm volatile("s_mov_b32 m0, %0\n\ts_nop 0\n\tglobal_load_lds_dwordx4 %1, off" ::"s"(lds_addr), "v"(gptr) : "memory");
}
DI float ex2(float x) { return __builtin_amdgcn_exp2f(x); }
DI float shx(float v, int lane, int mask) { return __int_as_float(__builtin_amdgcn_ds_bpermute((lane ^ mask) << 2, __float_as_int(v))); }
DI float shi(float v, int src) { return __int_as_float(__builtin_amdgcn_ds_bpermute(src << 2, __float_as_int(v))); }
DI float wave_sum(float v, int lane) {
#pragma unroll
  for (int o = 1; o < 64; o <<= 1) v += shx(v, lane, o);
  return v;
}

#define XB_TMO      128
#define XB_XCNT(j)  (256  + 64 * (j))
#define XB_XSUB(j)  (1280 + 64 * (j))
#define XB_XGEN(j)  (2304 + 64 * (j))
#define XB_TOP      3328
#define XB_TOPGEN   3392
#define XCD_BAR_WORDS 3456
#define XB_SPIN_CAP (1u << 18)
#define LAS __attribute__((address_space(3)))
DI unsigned xb_ld(unsigned* p) { return __hip_atomic_load(p, __ATOMIC_RELAXED, __HIP_MEMORY_SCOPE_AGENT); }
DI unsigned xb_add(unsigned* p, unsigned v) { return __hip_atomic_fetch_add(p, v, __ATOMIC_RELAXED, __HIP_MEMORY_SCOPE_AGENT); }
DI unsigned xb_xcc_id() { return (unsigned)__builtin_amdgcn_s_getreg((3 << 11) | 20) & 0xFu; }
#define XB_SPIN(cond, bar) do { unsigned _sp = 0; while (cond) { __builtin_amdgcn_s_sleep(1); \
    if ((++_sp & 255u) == 0u) { if (xb_ld(&(bar)[XB_TMO])) break; if (_sp > XB_SPIN_CAP) { atomicAdd(&(bar)[XB_TMO], 1u); break; } } } } while (0)
struct XcdBarrier { unsigned* bar; unsigned x; volatile LAS unsigned* st; };
DI XcdBarrier xcd_barrier_post(unsigned* bar, volatile LAS unsigned* st) {
  XcdBarrier b; b.bar = bar; b.x = xb_xcc_id(); b.st = st;
  if (threadIdx.x == 0) (void)xb_add(&bar[XB_XCNT(b.x)], 1u);
  return b;
}
DI void xcd_barrier_complete(unsigned* bar, unsigned x, unsigned& nloc, unsigned& nx) {
  const unsigned G = gridDim.x * gridDim.y * gridDim.z;
  unsigned sum, cnt, mine, sp = 0u;
  for (;;) {
    sum = 0u; cnt = 0u; mine = 0u;
#pragma unroll
    for (unsigned j = 0; j < 16; ++j) { const unsigned c = xb_ld(&bar[XB_XCNT(j)]); sum += c; cnt += (c > 0u) ? 1u : 0u; mine = (j == x) ? c : mine; }
    if (sum == G) break;
    __builtin_amdgcn_s_sleep(1);
    if ((++sp & 255u) == 0u) { if (xb_ld(&bar[XB_TMO])) break; if (sp > XB_SPIN_CAP) { atomicAdd(&bar[XB_TMO], 1u); break; } }
  }
  nloc = mine > 0u ? mine : 1u; nx = cnt > 0u ? cnt : 1u;
}
DI void xcd_barrier(const XcdBarrier& b) {
  asm volatile("s_waitcnt vmcnt(0)" ::: "memory");
  __syncthreads();
  if (threadIdx.x == 0) {
    unsigned* bar = b.bar;
    __builtin_amdgcn_s_waitcnt(0);
    unsigned nloc = b.st[0], nx = b.st[1];
    if (nloc == 0u) { xcd_barrier_complete(bar, b.x, nloc, nx); b.st[0] = nloc; b.st[1] = nx; }
    const unsigned old = xb_add(&bar[XB_XSUB(b.x)], 1u);
    const unsigned gen = old / nloc;
    if (old + 1u == (gen + 1u) * nloc) {
      __builtin_amdgcn_fence(__ATOMIC_RELEASE, "agent");
      asm volatile("s_waitcnt vmcnt(0)" ::: "memory");
      const unsigned og = xb_add(&bar[XB_TOP], 1u);
      const unsigned tg = og / nx;
      if (og + 1u == (tg + 1u) * nx) xb_add(&bar[XB_TOPGEN], 1u);
      else XB_SPIN(xb_ld(&bar[XB_TOPGEN]) == tg, bar);
      __builtin_amdgcn_fence(__ATOMIC_ACQUIRE, "agent");
      xb_add(&bar[XB_XGEN(b.x)], 1u);
      asm volatile("s_waitcnt vmcnt(0)" ::: "memory");
    } else {
      XB_SPIN(xb_ld(&bar[XB_XGEN(b.x)]) == gen, bar);
      __builtin_amdgcn_fence(__ATOMIC_ACQUIRE, "agent");
      asm volatile("s_waitcnt vmcnt(0)" ::: "memory");
    }
  }
  __syncthreads();
}

DI void phase0_mods(const Params& p, char* smem) {
  float* condS = (float*)smem;
  float* red = (float*)(smem + 17 * 512 * 4);
  float* mods = (float*)(p.ws + OFF_MODS);
  const int t = tid(), lane = t & 63, w = __builtin_amdgcn_readfirstlane(t >> 6);
  const int cq = t & 15, kg = t >> 4;
  for (int item = bid(); item < 4 * 96; item += gridDim.x) {
    const int l = item / 96, cb = item % 96;
    const int col = cb * 64 + cq * 4;
    float acc[17][4];
#pragma unroll
    for (int i = 0; i < 17; ++i) { acc[i][0] = 0.f; acc[i][1] = 0.f; acc[i][2] = 0.f; acc[i][3] = 0.f; }
    for (int kh = 0; kh < 2; ++kh) {
      __syncthreads();
      for (int e = t; e < 17 * 512; e += NTHR) {
        const int i = e >> 9, k = (e & 511) + kh * 512;
        const float v = (i < 16) ? p.c[i * 1024 + k] : p.c_ctx[k];
        condS[e] = v / (1.f + __expf(-v));
      }
      __syncthreads();
      const float* wp = p.w_ada + ((size_t)l * 1024 + kh * 512 + kg * 16) * 6144 + col;
#pragma unroll 2
      for (int kk = 0; kk < 16; ++kk) {
        const f32x4n wv = *(const f32x4n*)(wp + (size_t)kk * 6144);
#pragma unroll
        for (int i = 0; i < 17; ++i) {
          const float cv = condS[i * 512 + kg * 16 + kk];
          acc[i][0] += cv * wv.x; acc[i][1] += cv * wv.y; acc[i][2] += cv * wv.z; acc[i][3] += cv * wv.w;
        }
      }
    }
#pragma unroll
    for (int i = 0; i < 17; ++i)
#pragma unroll
      for (int j = 0; j < 4; ++j) {
        float v = acc[i][j];
        v += shx(v, lane, 16);
        v += shx(v, lane, 32);
        acc[i][j] = v;
      }
    __syncthreads();
    if (lane < 16) {
#pragma unroll
      for (int i = 0; i < 17; ++i)
#pragma unroll
        for (int j = 0; j < 4; ++j) red[(w * 17 + i) * 64 + cq * 4 + j] = acc[i][j];
    }
    __syncthreads();
    for (int e = t; e < 17 * 64; e += NTHR) {
      const int i = e >> 6, cc = e & 63;
      float s = 0.f;
#pragma unroll
      for (int ww = 0; ww < NWAVE; ++ww) s += red[(ww * 17 + i) * 64 + cc];
      mods[(size_t)(l * 17 + i) * 6144 + cb * 64 + cc] = s + p.b_ada[l * 6144 + cb * 64 + cc];
    }
  }
}

DI void transpose_tile(const float* __restrict__ src, int ldsrc, int k0, int c0, int c1, u16* __restrict__ dst, int lddst, int p0, float* tileS) {
  const int t = tid();
  __syncthreads();
  {
    const int n = t & 63;
    const int col = (n < 32) ? (c0 + n) : (c1 + n - 32);
#pragma unroll
    for (int j = 0; j < 8; ++j) {
      const int kk = (t >> 6) + 8 * j;
      tileS[kk * 65 + n] = src[(size_t)(k0 + kk) * ldsrc + col];
    }
  }
  __syncthreads();
  {
    const int kk2 = (t & 7) * 8;
    const int n2 = t >> 3;
    u32x4 o;
    o.x = pack2(tileS[(kk2 + 0) * 65 + n2], tileS[(kk2 + 1) * 65 + n2]);
    o.y = pack2(tileS[(kk2 + 2) * 65 + n2], tileS[(kk2 + 3) * 65 + n2]);
    o.z = pack2(tileS[(kk2 + 4) * 65 + n2], tileS[(kk2 + 5) * 65 + n2]);
    o.w = pack2(tileS[(kk2 + 6) * 65 + n2], tileS[(kk2 + 7) * 65 + n2]);
    *(u32x4*)(dst + (size_t)(p0 + n2) * lddst + k0 + kk2) = o;
  }
}

DI void phase0_weights(const Params& p, char* smem, int sel) {
  float* tileS = (float*)smem;
  for (int item = bid(); item < 11776; item += gridDim.x) {
    int it = item;
    if (it < 1536) {
      const int i = it / 768, r = it % 768, kt = r / 48, nt = r % 48;
      if ((i == 0) != (sel == 0)) continue;
      transpose_tile(p.w_in_ab + (size_t)i * 1024 * 3072, 3072, kt * 64, nt * 64, nt * 64 + 32,
                     (u16*)(p.ws + OFF_WIN_E) + (size_t)i * 3072 * 1024, 1024, nt * 64, tileS);
      continue;
    }
    it -= 1536;
    if (it < 768) {
      const int i = it / 384, r = it % 384, kt = r / 24, nt = r % 24;
      if (sel == 0) continue;
      transpose_tile(p.w_in_c + (size_t)i * 1024 * 1536, 1536, kt * 64, nt * 64, nt * 64 + 32,
                     (u16*)(p.ws + OFF_WIN_O) + (size_t)i * 1536 * 1024, 1024, nt * 64, tileS);
      continue;
    }
    it -= 768;
    if (it < 1024) {
      const int l = it / 256, r = it % 256, kt = r / 16, nt = r % 16;
      if ((l == 0) != (sel == 0)) continue;
      const float* src = ((l & 1) ? p.w_o_c : p.w_o_ab) + (size_t)(l >> 1) * 1024 * 1024;
      transpose_tile(src, 1024, kt * 64, nt * 64, nt * 64 + 32, (u16*)(p.ws + OFF_WO) + (size_t)l * 1024 * 1024, 1024, nt * 64, tileS);
      continue;
    }
    it -= 1024;
    if (it < 5632) {
      const int l = it / 1408, r = it % 1408, kt = r / 88, pt = r % 88;
      if ((l == 0) != (sel == 0)) continue;
      const int ntile = pt >> 2, wn = pt & 3;
      const int c0 = ntile * 128 + wn * 32;
      transpose_tile(p.w_up + (size_t)l * 1024 * 5632, 5632, kt * 64, c0, c0 + 2816,
                     (u16*)(p.ws + OFF_WUP) + (size_t)l * 5632 * 1024, 1024, pt * 64, tileS);
      continue;
    }
    it -= 5632;
    {
      const int l = it / 704, r = it % 704, kt = r / 16, nt = r % 16;
      if ((l == 0) != (sel == 0)) continue;
      transpose_tile(p.w_down + (size_t)l * 2816 * 1024, 1024, kt * 64, nt * 64, nt * 64 + 32,
                     (u16*)(p.ws + OFF_WD) + (size_t)l * 1024 * 2816, 2816, nt * 64, tileS);
    }
  }
}

DI void phase0_misc(const Params& p) {
  if (bid() != 0) return;
  const int t = tid();
  f32x2n* rope = (f32x2n*)(p.ws + OFF_ROPE);
  for (int e = t; e < 1024; e += NTHR) {
    const int pos = e >> 4, f = e & 15;
    const float inv = ex2(-(float)f * 0.8304820237218406f);
    const float ang = (float)pos * inv;
    rope[e] = f32x2n{__cosf(ang), __sinf(ang)};
  }
  if (t < 2) {
    const float* lv = p.diff_lambda + t * 256;
    float s1 = 0.f, s2 = 0.f;
    for (int k = 0; k < 64; ++k) { s1 += lv[k] * lv[64 + k]; s2 += lv[128 + k] * lv[192 + k]; }
    const float li = (t == 0) ? 0.2f : 0.47071301834358393f;
    ((float*)(p.ws + OFF_LAM))[t] = __expf(s1) - __expf(s2) + li;
  }
}

DI void phase_prep(const Params& p, int l, int which) {
  const int t = tid(), lane = t & 63, w = __builtin_amdgcn_readfirstlane(t >> 6);
  const int rows = (which == 1 && l == 3) ? NLAT : NROWS;
  const bool raw = (which == 0 && l == 0);
  const float* mods = (const float*)(p.ws + OFF_MODS);
  const float* g = raw ? nullptr : (which == 0 ? p.ln_g + ((l - 1) * 2 + 1) * 1024 : p.ln_g + (l * 2) * 1024);
  const float* bb = raw ? nullptr : (which == 0 ? p.ln_b + ((l - 1) * 2 + 1) * 1024 : p.ln_b + (l * 2) * 1024);
  _Float16* X = (_Float16*)(p.ws + OFF_X);
  u16* H = (u16*)(p.ws + OFF_H);
  constexpr int NR = 2;
  const int nwv = gridDim.x * NWAVE;
  for (int Rb = bid() * NWAVE + w; Rb < rows; Rb += nwv * NR) {
    float v[NR][16];
    int RR[NR];
#pragma unroll
    for (int u = 0; u < NR; ++u) {
      const int R0 = Rb + u * nwv;
      RR[u] = R0 < rows ? R0 : Rb;
    }
    if (raw) {
#pragma unroll
      for (int u = 0; u < NR; ++u) {
        const int R = RR[u];
        const float* src = (R < NLAT) ? p.x + (size_t)R * 1024 : p.ctx + (size_t)(R - NLAT) * 1024;
#pragma unroll
        for (int q = 0; q < 2; ++q) {
          const f32x4n a = *(const f32x4n*)(src + q * 512 + lane * 8);
          const f32x4n b = *(const f32x4n*)(src + q * 512 + lane * 8 + 4);
          v[u][q * 8 + 0] = a.x; v[u][q * 8 + 1] = a.y; v[u][q * 8 + 2] = a.z; v[u][q * 8 + 3] = a.w;
          v[u][q * 8 + 4] = b.x; v[u][q * 8 + 5] = b.y; v[u][q * 8 + 6] = b.z; v[u][q * 8 + 7] = b.w;
        }
      }
    } else {
#pragma unroll
      for (int u = 0; u < NR; ++u)
#pragma unroll
        for (int q = 0; q < 2; ++q) {
          const h8 a = *(const h8*)(X + (size_t)RR[u] * 1024 + q * 512 + lane * 8);
#pragma unroll
          for (int j = 0; j < 8; ++j) v[u][q * 8 + j] = (float)a[j];
        }
      float s[NR], mean[NR], s2[NR], rstd[NR];
#pragma unroll
      for (int u = 0; u < NR; ++u) {
        s[u] = 0.f;
#pragma unroll
        for (int j = 0; j < 16; ++j) s[u] += v[u][j];
      }
#pragma unroll
      for (int o = 1; o < 64; o <<= 1)
#pragma unroll
        for (int u = 0; u < NR; ++u) s[u] += shx(s[u], lane, o);
#pragma unroll
      for (int u = 0; u < NR; ++u) {
        mean[u] = s[u] * (1.f / 1024.f);
        s2[u] = 0.f;
#pragma unroll
        for (int j = 0; j < 16; ++j) { const float d = v[u][j] - mean[u]; s2[u] += d * d; }
      }
#pragma unroll
      for (int o = 1; o < 64; o <<= 1)
#pragma unroll
        for (int u = 0; u < NR; ++u) s2[u] += shx(s2[u], lane, o);
#pragma unroll
      for (int u = 0; u < NR; ++u) rstd[u] = rsqrtf(s2[u] * (1.f / 1024.f) + EPS);
#pragma unroll
      for (int q = 0; q < 2; ++q) {
        const int c = q * 512 + lane * 8;
        const f32x4n g0 = *(const f32x4n*)(g + c), g1 = *(const f32x4n*)(g + c + 4);
        const f32x4n b0 = *(const f32x4n*)(bb + c), b1 = *(const f32x4n*)(bb + c + 4);
        const float gg[8] = {g0.x, g0.y, g0.z, g0.w, g1.x, g1.y, g1.z, g1.w};
        const float bv[8] = {b0.x, b0.y, b0.z, b0.w, b1.x, b1.y, b1.z, b1.w};
#pragma unroll
        for (int u = 0; u < NR; ++u)
#pragma unroll
          for (int j = 0; j < 8; ++j) v[u][q * 8 + j] = (v[u][q * 8 + j] - mean[u]) * rstd[u] * gg[j] + bv[j];
      }
    }
#pragma unroll
    for (int u = 0; u < NR; ++u) {
      const int R = RR[u];
      const int mi = (R < NLAT) ? (R >> 11) : 16;
      const float* md = mods + (size_t)(l * 17 + mi) * 6144 + (which == 0 ? 0 : 3 * 1024);
#pragma unroll
      for (int q = 0; q < 2; ++q) {
        const int c = q * 512 + lane * 8;
        h8 xo;
#pragma unroll
        for (int j = 0; j < 8; ++j) xo[j] = (_Float16)v[u][q * 8 + j];
        *(h8*)(X + (size_t)R * 1024 + c) = xo;
        const f32x4n s0 = *(const f32x4n*)(md + c), s1 = *(const f32x4n*)(md + c + 4);
        const f32x4n c0 = *(const f32x4n*)(md + 1024 + c), c1 = *(const f32x4n*)(md + 1024 + c + 4);
        const float sh[8] = {s0.x, s0.y, s0.z, s0.w, s1.x, s1.y, s1.z, s1.w};
        const float sc[8] = {c0.x, c0.y, c0.z, c0.w, c1.x, c1.y, c1.z, c1.w};
        float hv[8];
#pragma unroll
        for (int j = 0; j < 8; ++j) hv[j] = v[u][q * 8 + j] * (1.f + sc[j]) + sh[j];
        u32x4 o;
        o.x = pack2(hv[0], hv[1]); o.y = pack2(hv[2], hv[3]); o.z = pack2(hv[4], hv[5]); o.w = pack2(hv[6], hv[7]);
        *(u32x4*)(H + (size_t)R * 1024 + c) = o;
      }
    }
  }
}

DI void phase_final(const Params& p) {
  const int t = tid(), lane = t & 63, w = __builtin_amdgcn_readfirstlane(t >> 6);
  const float* g = p.ln_g + (3 * 2 + 1) * 1024;
  const float* bb = p.ln_b + (3 * 2 + 1) * 1024;
  const _Float16* X = (const _Float16*)(p.ws + OFF_X);
  constexpr int NR = 2;
  const int nwv = gridDim.x * NWAVE;
  for (int Rb = bid() * NWAVE + w; Rb < NLAT; Rb += nwv * NR) {
    float v[NR][16];
    int RR[NR];
#pragma unroll
    for (int u = 0; u < NR; ++u) { const int R0 = Rb + u * nwv; RR[u] = R0 < NLAT ? R0 : Rb; }
#pragma unroll
    for (int u = 0; u < NR; ++u)
#pragma unroll
      for (int q = 0; q < 2; ++q) {
        const h8 a = *(const h8*)(X + (size_t)RR[u] * 1024 + q * 512 + lane * 8);
#pragma unroll
        for (int j = 0; j < 8; ++j) v[u][q * 8 + j] = (float)a[j];
      }
    float s[NR], mean[NR], s2[NR], rstd[NR];
#pragma unroll
    for (int u = 0; u < NR; ++u) {
      s[u] = 0.f;
#pragma unroll
      for (int j = 0; j < 16; ++j) s[u] += v[u][j];
    }
#pragma unroll
    for (int o = 1; o < 64; o <<= 1)
#pragma unroll
      for (int u = 0; u < NR; ++u) s[u] += shx(s[u], lane, o);
#pragma unroll
    for (int u = 0; u < NR; ++u) {
      mean[u] = s[u] * (1.f / 1024.f);
      s2[u] = 0.f;
#pragma unroll
      for (int j = 0; j < 16; ++j) { const float d = v[u][j] - mean[u]; s2[u] += d * d; }
    }
#pragma unroll
    for (int o = 1; o < 64; o <<= 1)
#pragma unroll
      for (int u = 0; u < NR; ++u) s2[u] += shx(s2[u], lane, o);
#pragma unroll
    for (int u = 0; u < NR; ++u) rstd[u] = rsqrtf(s2[u] * (1.f / 1024.f) + EPS);
#pragma unroll
    for (int q = 0; q < 2; ++q) {
      const int c = q * 512 + lane * 8;
      const f32x4n g0 = *(const f32x4n*)(g + c), g1 = *(const f32x4n*)(g + c + 4);
      const f32x4n b0 = *(const f32x4n*)(bb + c), b1 = *(const f32x4n*)(bb + c + 4);
#pragma unroll
      for (int u = 0; u < NR; ++u) {
        f32x4n o0, o1;
        o0.x = (v[u][q * 8 + 0] - mean[u]) * rstd[u] * g0.x + b0.x; o0.y = (v[u][q * 8 + 1] - mean[u]) * rstd[u] * g0.y + b0.y;
        o0.z = (v[u][q * 8 + 2] - mean[u]) * rstd[u] * g0.z + b0.z; o0.w = (v[u][q * 8 + 3] - mean[u]) * rstd[u] * g0.w + b0.w;
        o1.x = (v[u][q * 8 + 4] - mean[u]) * rstd[u] * g1.x + b1.x; o1.y = (v[u][q * 8 + 5] - mean[u]) * rstd[u] * g1.y + b1.y;
        o1.z = (v[u][q * 8 + 6] - mean[u]) * rstd[u] * g1.z + b1.z; o1.w = (v[u][q * 8 + 7] - mean[u]) * rstd[u] * g1.w + b1.w;
        *(f32x4n*)(p.out + (size_t)RR[u] * 1024 + c) = o0;
        *(f32x4n*)(p.out + (size_t)RR[u] * 1024 + c + 4) = o1;
      }
    }
  }
}

template <int MB, class Epi>
DI void gemm_tile(const u16* __restrict__ A, int lda, int row0, int Mrows, const u16* __restrict__ Bt, int ldb, int K, char* smem, Epi& epi, int rot) {
  char* As = smem;
  char* Bs = smem + 65536;
  const unsigned lds_base = (unsigned)(size_t)(lds_char*)smem;
  const int t = tid(), lane = t & 63, w = __builtin_amdgcn_readfirstlane(t >> 6), wm = w >> 2, wn = w & 3, r = lane & 31, h = lane >> 5;
  constexpr int NAJ = MB;
  const int lr = t >> 3;
  const int lch = (t & 7) ^ ((lr >> 1) & 7);
  unsigned aoff[NAJ];
#pragma unroll
  for (int j = 0; j < NAJ; ++j) {
    int gr = row0 + lr + 64 * j;
    gr = gr < 0 ? 0 : (gr > Mrows - 1 ? Mrows - 1 : gr);
    aoff[j] = (unsigned)gr * (unsigned)lda + lch * 8;
  }
  const u16* bp = Bt + (size_t)lr * ldb + lch * 8;
  f32x16 acc[2][MB];
#pragma unroll
  for (int nb = 0; nb < 2; ++nb)
#pragma unroll
    for (int mb = 0; mb < MB; ++mb)
#pragma unroll
      for (int i = 0; i < 16; ++i) acc[nb][mb][i] = 0.f;
  const int KT = K >> 6;
  int kcur = rot % KT;
#define GEMM_PIECE(STG, PC)                                                                                           \
  {                                                                                                                   \
    if ((PC) < NAJ)                                                                                                   \
      glds16(A + ko_ + aoff[(PC) < NAJ ? (PC) : 0], lds_base + (STG) * 32768 + (w * 64 + 512 * (PC)) * 16);           \
    else if ((PC) < NAJ + 4)                                                                                          \
      glds16(bp + ko_ + (size_t)(64 * ((PC) - NAJ)) * ldb,                                                            \
             lds_base + 65536 + (STG) * 32768 + (w * 64 + 512 * ((PC) - NAJ)) * 16);                                  \
  }
#define GEMM_STAGE(STG)                                                                                               \
  {                                                                                                                   \
    const int ko_ = kcur * 64;                                                                                        \
    _Pragma("unroll") for (int pc = 0; pc < NAJ + 4; ++pc) GEMM_PIECE(STG, pc)                                        \
  }
  GEMM_STAGE(0)
  asm volatile("s_waitcnt vmcnt(0)" ::: "memory");
  __syncthreads();
  const int sw = (r >> 1) & 7;
  int foff[4];
#pragma unroll
  for (int ks = 0; ks < 4; ++ks) foff[ks] = r * 128 + (((2 * ks + h) ^ sw) << 4);
  bf8 af[2][MB], bfr[2][2];
  {
    const char* as0 = As + wm * (32 * MB) * 128;
    const char* bs0 = Bs + wn * 64 * 128;
#pragma unroll
    for (int mb = 0; mb < MB; ++mb) af[0][mb] = *(const bf8*)(as0 + mb * 32 * 128 + foff[0]);
#pragma unroll
    for (int nb = 0; nb < 2; ++nb) bfr[0][nb] = *(const bf8*)(bs0 + nb * 32 * 128 + foff[0]);
  }
  const int kbase = rot % KT;
  if (KT > 1) {
    const int k1_ = (kbase + 1 >= KT) ? kbase + 1 - KT : kbase + 1;
    const int ko_ = k1_ * 64;
#pragma unroll
    for (int pc = 0; pc < 3; ++pc) GEMM_PIECE(1, pc)
  }
  for (int kt = 0; kt < KT; ++kt) {
    const bool more = (kt + 1 < KT);
    const bool more2 = (kt + 2 < KT);
    const int nstg = (kt + 1) & 1;
    const char* as = As + (kt & 1) * 32768 + wm * (32 * MB) * 128;
    const char* bs = Bs + (kt & 1) * 32768 + wn * 64 * 128;
    int k1_ = kbase + kt + 1; if (k1_ >= KT) k1_ -= KT;
    int k2_ = kbase + kt + 2; if (k2_ >= KT) k2_ -= KT; if (k2_ >= KT) k2_ -= KT;
#pragma unroll
    for (int ks = 0; ks < 3; ++ks) {
#pragma unroll
      for (int idx = 0; idx < 2 * MB; ++idx) {
        const int nb = idx / MB, mb = idx % MB;
        acc[nb][mb] = mfma32(bfr[ks & 1][nb], af[ks & 1][mb], acc[nb][mb]);
        if (idx < MB) af[(ks + 1) & 1][idx] = *(const bf8*)(as + idx * 32 * 128 + foff[ks + 1]);
        else if (idx < MB + 2) bfr[(ks + 1) & 1][idx - MB] = *(const bf8*)(bs + (idx - MB) * 32 * 128 + foff[ks + 1]);
        if (more && ks < 2 && idx < 3) {
          const int ko_ = k1_ * 64;
          GEMM_PIECE(nstg, 3 + ks * 3 + idx)
        }
        __builtin_amdgcn_sched_barrier(0);
      }
    }
    if (more) {
      asm volatile("s_waitcnt vmcnt(0)" ::: "memory");
      __syncthreads();
      if (more2) {
        const int ko_ = k2_ * 64;
#pragma unroll
        for (int pc = 0; pc < 3; ++pc) GEMM_PIECE(kt & 1, pc)
      }
      __builtin_amdgcn_sched_barrier(0);
      const char* asn = As + nstg * 32768 + wm * (32 * MB) * 128;
      const char* bsn = Bs + nstg * 32768 + wn * 64 * 128;
#pragma unroll
      for (int mb = 0; mb < MB; ++mb) af[0][mb] = *(const bf8*)(asn + mb * 32 * 128 + foff[0]);
#pragma unroll
      for (int nb = 0; nb < 2; ++nb) bfr[0][nb] = *(const bf8*)(bsn + nb * 32 * 128 + foff[0]);
    }
#pragma unroll
    for (int nb = 0; nb < 2; ++nb)
#pragma unroll
      for (int mb = 0; mb < MB; ++mb) acc[nb][mb] = mfma32(bfr[1][nb], af[1][mb], acc[nb][mb]);
#pragma unroll
    for (int gk = 0; gk < 2 * MB; ++gk) {
      __builtin_amdgcn_sched_group_barrier(0x008, 1, 0);
      __builtin_amdgcn_sched_group_barrier(0x100, 1, 0);
    }
    __builtin_amdgcn_sched_barrier(0);
  }
  __syncthreads();
  epi(acc, wm, wn, r, h);
}

template <int MB>
struct EpiRes {
  _Float16* X; const float* gate; int row0, n0; u16* ostage;
  DI void operator()(f32x16 (&acc)[2][MB], int wm, int wn, int r, int h) {
    u16* slab = ostage + (wm * 4 + wn) * (64 * 72);
    const int lane = h * 32 + r;
#pragma unroll
    for (int mb = 0; mb < MB; ++mb) {
      const int tokl = (mb & 1) * 32 + r;
#pragma unroll
      for (int nb = 0; nb < 2; ++nb)
#pragma unroll
        for (int ig = 0; ig < 4; ++ig) {
          u32x2 o;
          o.x = pack2(acc[nb][mb][ig * 4 + 0], acc[nb][mb][ig * 4 + 1]);
          o.y = pack2(acc[nb][mb][ig * 4 + 2], acc[nb][mb][ig * 4 + 3]);
          *(u32x2*)(slab + tokl * 72 + nb * 32 + ig * 8 + h * 4) = o;
        }
      if ((mb & 1) || mb == MB - 1) {
        asm volatile("s_waitcnt lgkmcnt(0)" ::: "memory");
        const int ntok = (mb & 1) ? 64 : 32;
        const int R0 = row0 + wm * (32 * MB) + (mb >> 1) * 64;
#pragma unroll
        for (int j = 0; j < 8; ++j) {
          const int rowl = (lane >> 3) + 8 * j, ch = lane & 7;
          if (rowl < ntok) {
            const u32x4 yv = *(const u32x4*)(slab + rowl * 72 + ch * 8);
            const int R = R0 + rowl;
            const int mi = (R < NLAT) ? (R >> 11) : 16;
            const int col = n0 + wn * 64 + ch * 8;
            const float* g = gate + (size_t)mi * 6144 + col;
            const f32x4n g0 = *(const f32x4n*)(g), g1 = *(const f32x4n*)(g + 4);
            _Float16* xp = X + (size_t)R * 1024 + col;
            const h8 xv = *(const h8*)xp;
            const float y[8] = {__uint_as_float(yv.x << 16), __uint_as_float(yv.x & 0xffff0000u), __uint_as_float(yv.y << 16), __uint_as_float(yv.y & 0xffff0000u),
                                __uint_as_float(yv.z << 16), __uint_as_float(yv.z & 0xffff0000u), __uint_as_float(yv.w << 16), __uint_as_float(yv.w & 0xffff0000u)};
            const float gg[8] = {g0.x, g0.y, g0.z, g0.w, g1.x, g1.y, g1.z, g1.w};
            h8 o;
#pragma unroll
            for (int q = 0; q < 8; ++q) o[q] = (_Float16)(ALPHA * (float)xv[q] + gg[q] * y[q]);
            *(h8*)xp = o;
          }
        }
      }
    }
    __syncthreads();
  }
};

struct EpiQKV {
  int odd, row0, ntile;
  u16 *QO, *Kb, *VT;
  const f32x2n* rope;
  const float* qkn;
  u16* ostage;
  DI void operator()(f32x16 (&acc)[2][4], int wm, int wn, int r, int h) {
    const int cgi = ntile * 4 + wn;
    u16* slab = ostage + (wm * 4 + wn) * (64 * 72);
    int kind, dst, do_rope, do_norm;
    if (!odd) {
      const int seg = cgi >> 3, idx = cgi & 7;
      kind = seg % 3;
      do_rope = (seg == 3 || seg == 4);
      do_norm = 0;
      if (seg == 0) dst = idx * 64;
      else if (seg == 1) dst = idx;
      else if (seg == 2) dst = idx * 64;
      else if (seg == 3) dst = 512 + idx * 64;
      else if (seg == 4) dst = 8 + idx;
      else dst = 512 + idx * 64;
    } else {
      if (cgi < 16) { kind = 0; dst = cgi * 64; do_rope = 1; do_norm = 1; }
      else if (cgi < 20) { kind = 1; dst = cgi - 16; do_rope = 1; do_norm = 1; }
      else { kind = 2; dst = (cgi - 20) * 64; do_rope = 0; do_norm = 0; }
    }
    const int nkh = odd ? 4 : 16, nvr = odd ? 256 : 1024;
    const float* gn = qkn + (kind == 1 ? 64 : 0);
#pragma unroll
    for (int mb = 0; mb < 4; ++mb) {
      const int R = row0 + wm * 128 + mb * 32 + r;
      const bool lat = R < NLAT;
      const int b = lat ? (R >> 11) : ((R - NLAT) >> 8);
      const int tu = lat ? (R & 2047) : 2048 + ((R - NLAT) & 255);
      float v[2][16];
#pragma unroll
      for (int nb = 0; nb < 2; ++nb)
#pragma unroll
        for (int i = 0; i < 16; ++i) v[nb][i] = acc[nb][mb][i];
      if (do_norm) {
        float ss = 0.f;
#pragma unroll
        for (int nb = 0; nb < 2; ++nb)
#pragma unroll
          for (int i = 0; i < 16; ++i) ss += v[nb][i] * v[nb][i];
        ss += shx(ss, (h * 32 + r), 32);
        const float rs = rsqrtf(ss * (1.f / 64.f) + EPS);
#pragma unroll
        for (int nb = 0; nb < 2; ++nb)
#pragma unroll
          for (int ig = 0; ig < 4; ++ig) {
            const f32x4n gv = *(const f32x4n*)(gn + nb * 32 + ig * 8 + h * 4);
            v[nb][ig * 4 + 0] *= rs * gv.x; v[nb][ig * 4 + 1] *= rs * gv.y;
            v[nb][ig * 4 + 2] *= rs * gv.z; v[nb][ig * 4 + 3] *= rs * gv.w;
          }
      }
      if (do_rope && lat) {
#pragma unroll
        for (int nb = 0; nb < 2; ++nb) {
          const int pos = (nb == 0) ? (tu >> 6) : (tu & 63);
#pragma unroll
          for (int i = 0; i < 8; ++i) {
            const f32x2n cs = rope[pos * 16 + crow(i, h)];
            const float x1 = v[nb][i], x2 = v[nb][i + 8];
            v[nb][i] = x1 * cs.x - x2 * cs.y;
            v[nb][i + 8] = x2 * cs.x + x1 * cs.y;
          }
        }
      }
      const int tokl = (mb & 1) * 32 + r;
      if (kind == 2) {
#pragma unroll
        for (int nb = 0; nb < 2; ++nb)
#pragma unroll
          for (int i = 0; i < 16; ++i) slab[(nb * 32 + crow(i, h)) * 72 + tokl] = f2bf(v[nb][i]);
      } else {
#pragma unroll
        for (int nb = 0; nb < 2; ++nb)
#pragma unroll
          for (int ig = 0; ig < 4; ++ig) {
            u32x2 o;
            o.x = pack2(v[nb][ig * 4 + 0], v[nb][ig * 4 + 1]);
            o.y = pack2(v[nb][ig * 4 + 2], v[nb][ig * 4 + 3]);
            *(u32x2*)(slab + tokl * 72 + nb * 32 + ig * 8 + h * 4) = o;
          }
      }
      if (mb & 1) {
        asm volatile("s_waitcnt lgkmcnt(0)" ::: "memory");
        const int lane = h * 32 + r;
        const int R0 = row0 + wm * 128 + (mb >> 1) * 64;
        const bool lat0 = R0 < NLAT;
        const int b0 = lat0 ? (R0 >> 11) : ((R0 - NLAT) >> 8);
        const int tu0 = lat0 ? (R0 & 2047) : 2048 + ((R0 - NLAT) & 255);
#pragma unroll
        for (int j = 0; j < 8; ++j) {
          const int rowl = (lane >> 3) + 8 * j, ch = lane & 7;
          const u32x4 val = *(const u32x4*)(slab + rowl * 72 + ch * 8);
          u16* dp;
          if (kind == 2) dp = VT + ((size_t)b0 * nvr + dst + rowl) * T + tu0 + ch * 8;
          else if (kind == 0) dp = QO + (size_t)(R0 + rowl) * 1024 + dst + ch * 8;
          else dp = Kb + (((size_t)b0 * nkh + dst) * T + tu0 + rowl) * 64 + ch * 8;
          *(u32x4*)dp = val;
        }
      }
    }
    __syncthreads();
  }
};

DI float gelu_tanh(float g) {
  const float u = g * g;
  const float t = g * (-2.302208198f - 0.1029432397f * u);
  const float e = ex2(t);
  return g * __builtin_amdgcn_rcpf(1.f + e);
}

struct EpiUp {
  u16* act; const float* cw; const float* cb; int row0, Mrows, nt; float* edge; u16* ostage;
  DI void operator()(f32x16 (&acc)[2][4], int wm, int wn, int r, int h) {
    float* eb = edge + ((wm * 4 + wn) * 2) * 64;
    if (r == 0) {
#pragma unroll
      for (int nb = 0; nb < 2; ++nb)
#pragma unroll
        for (int i = 0; i < 16; ++i) eb[nb * 32 + crow(i, h)] = acc[nb][0][i];
    }
    if (r == 31) {
#pragma unroll
      for (int nb = 0; nb < 2; ++nb)
#pragma unroll
        for (int i = 0; i < 16; ++i) eb[64 + nb * 32 + crow(i, h)] = acc[nb][3][i];
    }
    __syncthreads();
    const float* ob = edge + (((wm ^ 1) * 4 + wn) * 2) * 64 + (wm == 0 ? 0 : 64);
    const int sp = (h << 5) | ((r - 1) & 31), sn = (h << 5) | ((r + 1) & 31);
    const int Rb = row0 + wm * 128 + r;
    u16* ost = ostage + (wm * 4 + wn) * (128 * 40);
    float pm[4], nm[4];
#pragma unroll
    for (int mb = 0; mb < 4; ++mb) {
      const int R = Rb + mb * 32;
      const bool lat = R < NLAT;
      const int tt = lat ? (R & 2047) : ((R - NLAT) & 255);
      pm[mb] = (tt == 0) ? 0.f : 1.f;
      nm[mb] = (tt == (lat ? 2047 : 255)) ? 0.f : 1.f;
    }
#pragma unroll
    for (int ig = 0; ig < 4; ++ig)
#pragma unroll
      for (int qp = 0; qp < 2; ++qp) {
        const int i0 = ig * 4 + qp * 2;
        float u[2][4][2];
#pragma unroll
        for (int nb = 0; nb < 2; ++nb) {
          int xp[4];
#pragma unroll
          for (int mb = 0; mb < 4; ++mb) xp[mb] = (int)pack2(acc[nb][mb][i0], acc[nb][mb][i0 + 1]);
          const float eo0 = ob[nb * 32 + crow(i0, h)], eo1 = ob[nb * 32 + crow(i0 + 1, h)];
          float w0[2], w1[2], w2[2], bz[2];
          {
            const int ff = nt * 128 + wn * 32 + crow(i0, h) + nb * DFF;
            const f32x2n a0 = *(const f32x2n*)(cw + ff), a1 = *(const f32x2n*)(cw + 2 * DFF + ff), a2 = *(const f32x2n*)(cw + 4 * DFF + ff),
                         a3 = *(const f32x2n*)(cb + ff);
            w0[0] = a0.x; w0[1] = a0.y; w1[0] = a1.x; w1[1] = a1.y; w2[0] = a2.x; w2[1] = a2.y; bz[0] = a3.x; bz[1] = a3.y;
          }
          int spm = 0;
#pragma unroll
          for (int mb = 0; mb < 4; ++mb) {
            const int spc = __builtin_amdgcn_ds_bpermute(sp << 2, xp[mb]);
            const int snc = __builtin_amdgcn_ds_bpermute(sn << 2, xp[mb]);
            const int snn = (mb < 3) ? __builtin_amdgcn_ds_bpermute(sn << 2, xp[mb < 3 ? mb + 1 : 3]) : 0;
            const int pv = (mb > 0) ? ((r == 0) ? spm : spc) : spc;
            const int nv = (mb < 3) ? ((r == 31) ? snn : snc) : snc;
            float prev0 = __int_as_float(pv << 16), prev1 = __int_as_float(pv & 0xffff0000);
            float next0 = __int_as_float(nv << 16), next1 = __int_as_float(nv & 0xffff0000);
            if (mb == 0 && r == 0) { prev0 = eo0; prev1 = eo1; }
            if (mb == 3 && r == 31) { next0 = eo0; next1 = eo1; }
            spm = spc;
            prev0 *= pm[mb]; prev1 *= pm[mb];
            next0 *= nm[mb]; next1 *= nm[mb];
            u[nb][mb][0] = w0[0] * prev0 + w1[0] * acc[nb][mb][i0] + w2[0] * next0 + bz[0];
            u[nb][mb][1] = w0[1] * prev1 + w1[1] * acc[nb][mb][i0 + 1] + w2[1] * next1 + bz[1];
          }
        }
#pragma unroll
        for (int mb = 0; mb < 4; ++mb)
          *(unsigned*)(ost + (mb * 32 + r) * 40 + ig * 8 + h * 4 + qp * 2) =
              pack2(gelu_tanh(u[1][mb][0]) * u[0][mb][0], gelu_tanh(u[1][mb][1]) * u[0][mb][1]);
      }
    asm volatile("s_waitcnt lgkmcnt(0)" ::: "memory");
    const int lane = h * 32 + r;
#pragma unroll
    for (int j = 0; j < 8; ++j) {
      const int tk = (lane >> 2) + 16 * j, ch = lane & 3;
      const int tr = wm * 128 + tk;
      const int R = row0 + tr;
      const u32x4 v = *(const u32x4*)(ost + tk * 40 + ch * 8);
      if ((tr >= 1) && (tr <= 254) && (R >= 0) && (R < Mrows))
        *(u32x4*)(act + (size_t)R * DFF + nt * 128 + wn * 32 + ch * 8) = v;
    }
    __syncthreads();
  }
};

DI bool tile_map(int id, int NT, int MT, int& mt, int& nt) {
  const int x = id & 7, q = id >> 3;
  nt = q % NT;
  mt = (q / NT) * 8 + x;
  return mt < MT;
}

DI void phase_qkv(const Params& p, int l, char* smem) {
  const int odd = l & 1;
  const int NT = odd ? 6 : 12;
  const u16* W = odd ? (const u16*)(p.ws + OFF_WIN_O) + (size_t)(l >> 1) * 1536 * 1024 : (const u16*)(p.ws + OFF_WIN_E) + (size_t)(l >> 1) * 3072 * 1024;
  const u16* H = (const u16*)(p.ws + OFF_H);
  for (int tile = bid(); tile < 144 * NT; tile += gridDim.x) {
    int mt, nt;
    if (!tile_map(tile, NT, 144, mt, nt)) continue;
    EpiQKV e;
    e.odd = odd; e.row0 = mt * 256; e.ntile = nt;
    e.QO = (u16*)(p.ws + OFF_QO); e.Kb = (u16*)(p.ws + OFF_K); e.VT = (u16*)(p.ws + OFF_VT);
    e.rope = (const f32x2n*)(p.ws + OFF_ROPE);
    e.qkn = p.gqa_qk_norm + (l >> 1) * 128;
    e.ostage = (u16*)smem;
    gemm_tile<4>(H, 1024, mt * 256, NROWS, W + (size_t)nt * 256 * 1024, 1024, 1024, smem, e, tile);
  }
}

struct EpiNull {
  float* sink;
  DI void operator()(f32x16 (&acc)[2][4], int wm, int wn, int r, int h) {
    float s = 0.f;
#pragma unroll
    for (int nb = 0; nb < 2; ++nb)
#pragma unroll
      for (int mb = 0; mb < 4; ++mb)
#pragma unroll
        for (int i = 0; i < 16; ++i) s += acc[nb][mb][i];
    if (s == 123.456f) *sink = s;
  }
};
DI void phase_qkv_null(const Params& p, int l, char* smem) {
  const int odd = l & 1;
  const int NT = odd ? 6 : 12;
  const u16* W = odd ? (const u16*)(p.ws + OFF_WIN_O) + (size_t)(l >> 1) * 1536 * 1024 : (const u16*)(p.ws + OFF_WIN_E) + (size_t)(l >> 1) * 3072 * 1024;
  const u16* H = (const u16*)(p.ws + OFF_H);
  for (int tile = bid(); tile < 144 * NT; tile += gridDim.x) {
    int mt, nt;
    if (!tile_map(tile, NT, 144, mt, nt)) continue;
    EpiNull e;
    e.sink = (float*)(p.ws + OFF_LAM + 64);
    gemm_tile<4>(H, 1024, mt * 256, NROWS, W + (size_t)nt * 256 * 1024, 1024, 1024, smem, e, tile);
  }
}

template <int MB>
DI void phase_res_t(const Params& p, int l, int which, char* smem) {
  constexpr int TR = 64 * MB;
  const int rows = (l == 3) ? NLAT : NROWS;
  const int MT = rows / TR;
  const u16* A = which ? (const u16*)(p.ws + OFF_ACT) : (const u16*)(p.ws + OFF_QO);
  const int lda = which ? DFF : 1024, K = which ? DFF : 1024;
  const u16* W = which ? (const u16*)(p.ws + OFF_WD) + (size_t)l * 1024 * DFF : (const u16*)(p.ws + OFF_WO) + (size_t)l * 1024 * 1024;
  const float* gate = (const float*)(p.ws + OFF_MODS) + (size_t)l * 17 * 6144 + (which ? 5 : 2) * 1024;
  for (int tile = bid(); tile < MT * 4; tile += gridDim.x) {
    int mt, nt;
    if (!tile_map(tile, 4, MT, mt, nt)) continue;
    EpiRes<MB> e;
    e.X = (_Float16*)(p.ws + OFF_X); e.gate = gate; e.row0 = mt * TR; e.n0 = nt * 256; e.ostage = (u16*)smem;
    gemm_tile<MB>(A, lda, mt * TR, rows, W + (size_t)nt * 256 * K, K, K, smem, e, tile);
  }
}
DI void phase_res(const Params& p, int l, int which, char* smem) {
  if (l == 3) phase_res_t<4>(p, l, which, smem);
  else phase_res_t<3>(p, l, which, smem);
}

DI void phase_up(const Params& p, int l, char* smem) {
  const int rows = (l == 3) ? NLAT : NROWS;
  const int MT = (rows + 253) / 254;
  const int MTP = (MT + 7) & ~7;
  const u16* W = (const u16*)(p.ws + OFF_WUP) + (size_t)l * 5632 * 1024;
  const u16* H = (const u16*)(p.ws + OFF_H);
  for (int tile = bid(); tile < MTP * 22; tile += gridDim.x) {
    int mt, nt;
    if (!tile_map(tile, 22, MT, mt, nt)) continue;
    EpiUp e;
    e.act = (u16*)(p.ws + OFF_ACT); e.cw = p.conv_w + (size_t)l * 3 * 5632; e.cb = p.conv_b + (size_t)l * 5632;
    e.row0 = mt * 254 - 1; e.Mrows = rows; e.nt = nt; e.edge = (float*)(smem + 131072); e.ostage = (u16*)smem;
    gemm_tile<4>(H, 1024, mt * 254 - 1, rows, W + (size_t)nt * 256 * 1024, 1024, 1024, smem, e, tile);
  }
}

struct AttnArgs {
  u16* qo;
  const u16 *k1, *k2, *vt;
  int s0, n0, n1;
  const float* rpb;
  int rq0, us;
  float lam, oml;
  const float* subln;
};

template <int DV, int MODE>
DI void attn_item(const AttnArgs& a, char* smem) {
  u16* Ks1 = (u16*)smem;
  u16* Ks2 = (u16*)(smem + 9216);
  u16* Vs = (u16*)(smem + 18432);
  float* rpbS = (float*)(smem + 36864);
  const int t = tid(), lane = t & 63, w = __builtin_amdgcn_readfirstlane(t >> 6), r = lane & 31, h = lane >> 5;
  constexpr int NDV = DV / 32;
  constexpr int NVL = DV / 64;
  const int nt = a.n0 + a.n1;

  const int qrow = (MODE == 1) ? ((w & 3) * 32 + r) : (w * 32 + r);
  const int qcoff = (MODE == 1) ? ((w >> 2) * 64) : 0;
  u16* qp = a.qo + (size_t)qrow * 1024;
  bf8 qf[4];
#pragma unroll
  for (int ks = 0; ks < 4; ++ks) qf[ks] = *(const bf8*)(qp + qcoff + ks * 16 + h * 8);
  const u16* Ks = (MODE == 1 && (w >> 2)) ? Ks2 : Ks1;

  int rq = 0, qc = 0, cs = 0, rsw = 0;
  if (MODE == 2) {
    __syncthreads();
    for (int e = t; e < 15 * 32; e += NTHR) {
      const int dr = e >> 5, dc = e & 31;
      rpbS[e] = (dc < 31) ? a.rpb[dr * 31 + dc] * LOG2E : 0.f;
    }
    rq = a.rq0 + (w >> 1);
    qc = (w & 1) * 32 + r;
    cs = qc - 8; cs = cs < 0 ? 0 : (cs > 48 ? 48 : cs);
    rsw = rq - 4; rsw = rsw < 0 ? 0 : (rsw > 24 ? 24 : rsw);
  }

  f32x16 O[NDV];
#pragma unroll
  for (int d = 0; d < NDV; ++d)
#pragma unroll
    for (int i = 0; i < 16; ++i) O[d][i] = 0.f;
  float m = -1e30f, lsum = 0.f;

  u32x4 rk1, rk2, rv[NVL];
  const int srow = t >> 3, sch = t & 7;
#define ATTN_FETCH(TT)                                                                                         \
  {                                                                                                            \
    const int tt_ = (TT);                                                                                      \
    const int key0_ = tt_ < a.n0 ? a.s0 + tt_ * 64 : 2048 + (tt_ - a.n0) * 64;                                 \
    rk1 = *(const u32x4*)(a.k1 + (size_t)(key0_ + srow) * 64 + sch * 8);                                       \
    if (MODE == 1) rk2 = *(const u32x4*)(a.k2 + (size_t)(key0_ + srow) * 64 + sch * 8);                        \
    _Pragma("unroll") for (int j = 0; j < NVL; ++j)                                                            \
        rv[j] = *(const u32x4*)(a.vt + (size_t)(srow + 64 * j) * T + key0_ + sch * 8);                         \
  }
  if (nt > 0) ATTN_FETCH(0)
  for (int tt = 0; tt < nt; ++tt) {
    __syncthreads();
    *(u32x4*)(Ks1 + srow * 72 + sch * 8) = rk1;
    if (MODE == 1) *(u32x4*)(Ks2 + srow * 72 + sch * 8) = rk2;
#pragma unroll
    for (int j = 0; j < NVL; ++j) *(u32x4*)(Vs + (srow + 64 * j) * 72 + sch * 8) = rv[j];
    __syncthreads();
    if (tt + 1 < nt) ATTN_FETCH(tt + 1)
    __builtin_amdgcn_sched_barrier(0);

    bool active = true;
    int kr = 0;
    const bool local = (MODE == 2) && (tt < a.n0);
    if (local) { kr = a.us + tt; active = (kr >= rsw) && (kr < rsw + 8); }
    if (active) {
      f32x16 s[2];
#pragma unroll
      for (int kb = 0; kb < 2; ++kb) {
#pragma unroll
        for (int i = 0; i < 16; ++i) s[kb][i] = 0.f;
#pragma unroll
        for (int ks = 0; ks < 4; ++ks) {
          const bf8 kf = *(const bf8*)(Ks + (kb * 32 + r) * 72 + ks * 16 + h * 8);
          s[kb] = mfma32(kf, qf[ks], s[kb]);
        }
      }
      constexpr float SC = 0.125f * LOG2E;
      float mx = -INFINITY;
      if (local) {
#pragma unroll
        for (int kb = 0; kb < 2; ++kb)
#pragma unroll
          for (int i = 0; i < 16; ++i) {
            const int kc = kb * 32 + crow(i, h);
            const bool ok = (kc >= cs) && (kc < cs + 16);
            const int dc = kc - qc + 15;
            const int dr = kr - rq + 7;
            const float bias = rpbS[dr * 32 + (ok ? dc : 0)];
            const float v = ok ? (s[kb][i] + bias * (1.f / SC)) : -INFINITY;
            s[kb][i] = v;
            mx = fmaxf(mx, v);
          }
      } else {
#pragma unroll
        for (int kb = 0; kb < 2; ++kb)
#pragma unroll
          for (int i = 0; i < 16; i += 2) mx = fmaxf(fmaxf(mx, s[kb][i]), s[kb][i + 1]);
      }
      mx = fmaxf(mx, shx(mx, lane, 32)) * SC;
      const float mn = fmaxf(m, mx);
      const bool resc = __builtin_amdgcn_ballot_w64(mn != m) != 0ull;
      float ps0 = 0.f, ps1 = 0.f;
#pragma unroll
      for (int kb = 0; kb < 2; ++kb)
#pragma unroll
        for (int i = 0; i < 16; i += 2) {
          f32x2n v = {s[kb][i], s[kb][i + 1]};
          v = v * f32x2n{SC, SC} - f32x2n{mn, mn};
          const float p0 = ex2(v.x), p1 = ex2(v.y);
          s[kb][i] = p0; s[kb][i + 1] = p1;
          ps0 += p0; ps1 += p1;
        }
      if (resc) {
        const float alpha = ex2(m - mn);
        m = mn;
        lsum *= alpha;
#pragma unroll
        for (int d = 0; d < NDV; ++d)
#pragma unroll
          for (int i = 0; i < 16; ++i) O[d][i] *= alpha;
      }
      lsum += ps0 + ps1;
#pragma unroll
      for (int kb = 0; kb < 2; ++kb)
#pragma unroll
        for (int s2 = 0; s2 < 2; ++s2) {
          u32x4 pk;
          pk.x = pack2(s[kb][s2 * 8 + 0], s[kb][s2 * 8 + 1]);
          pk.y = pack2(s[kb][s2 * 8 + 2], s[kb][s2 * 8 + 3]);
          pk.z = pack2(s[kb][s2 * 8 + 4], s[kb][s2 * 8 + 5]);
          pk.w = pack2(s[kb][s2 * 8 + 6], s[kb][s2 * 8 + 7]);
          const bf8 pf = __builtin_bit_cast(bf8, pk);
#pragma unroll
          for (int d = 0; d < NDV; ++d) {
            const u16* vp = Vs + (d * 32 + r) * 72 + kb * 32 + s2 * 16 + 4 * h;
            u32x4 vv;
            const u32x2 lo = *(const u32x2*)(vp);
            const u32x2 hi = *(const u32x2*)(vp + 8);
            vv.x = lo.x; vv.y = lo.y; vv.z = hi.x; vv.w = hi.y;
            O[d] = mfma32(__builtin_bit_cast(bf8, vv), pf, O[d]);
          }
        }
    }
  }
  const float ltot = lsum + shx(lsum, lane, 32);
  const float inv = 1.f / ltot;
  if (MODE != 1) {
#pragma unroll
    for (int d = 0; d < NDV; ++d)
#pragma unroll
      for (int ig = 0; ig < 4; ++ig) {
        u32x2 o;
        o.x = pack2(O[d][ig * 4 + 0] * inv, O[d][ig * 4 + 1] * inv);
        o.y = pack2(O[d][ig * 4 + 2] * inv, O[d][ig * 4 + 3] * inv);
        *(u32x2*)(qp + d * 32 + ig * 8 + h * 4) = o;
      }
  } else {
    float* comb = (float*)smem;
    __syncthreads();
    if (w >= 4) {
#pragma unroll
      for (int d = 0; d < NDV; ++d)
#pragma unroll
        for (int i = 0; i < 16; ++i) comb[((w - 4) * 128 + d * 32 + crow(i, h)) * 32 + r] = O[d][i] * inv;
    }
    __syncthreads();
    if (w < 4) {
      float ss = 0.f;
#pragma unroll
      for (int d = 0; d < NDV; ++d)
#pragma unroll
        for (int i = 0; i < 16; ++i) {
          const float o = O[d][i] * inv - a.lam * comb[(w * 128 + d * 32 + crow(i, h)) * 32 + r];
          O[d][i] = o;
          ss += o * o;
        }
      ss += shx(ss, lane, 32);
      const float rs = rsqrtf(ss * (1.f / 128.f) + EPS) * a.oml;
#pragma unroll
      for (int d = 0; d < NDV; ++d)
#pragma unroll
        for (int ig = 0; ig < 4; ++ig) {
          const f32x4n gv = *(const f32x4n*)(a.subln + d * 32 + ig * 8 + h * 4);
          u32x2 o;
          o.x = pack2(O[d][ig * 4 + 0] * rs * gv.x, O[d][ig * 4 + 1] * rs * gv.y);
          o.y = pack2(O[d][ig * 4 + 2] * rs * gv.z, O[d][ig * 4 + 3] * rs * gv.w);
          *(u32x2*)(qp + d * 32 + ig * 8 + h * 4) = o;
        }
    }
  }
}

DI void attn_item_q64(const AttnArgs& a, char* smem) {
  char* Kb_ = smem;
  char* Vb_ = smem + 16384;
  const unsigned lds_base = (unsigned)(size_t)(lds_char*)smem;
  const int t = tid(), lane = t & 63, w = __builtin_amdgcn_readfirstlane(t >> 6), r = lane & 31, h = lane >> 5;
  const int nt = a.n0 + a.n1;
  u16* qp[2];
  bf8 qf[2][4];
#pragma unroll
  for (int q2 = 0; q2 < 2; ++q2) {
    qp[q2] = a.qo + (size_t)(w * 64 + q2 * 32 + r) * 1024;
#pragma unroll
    for (int ks = 0; ks < 4; ++ks) qf[q2][ks] = *(const bf8*)(qp[q2] + ks * 16 + h * 8);
  }
  f32x16 O[2][2];
#pragma unroll
  for (int q2 = 0; q2 < 2; ++q2)
#pragma unroll
    for (int d = 0; d < 2; ++d)
#pragma unroll
      for (int i = 0; i < 16; ++i) O[q2][d][i] = 0.f;
  float m[2] = {-1e30f, -1e30f}, lsum[2] = {0.f, 0.f};
  const int srow = t >> 3, sch = (t & 7) ^ ((srow >> 1) & 7);
  const u16* kg = a.k1 + (size_t)srow * 64 + sch * 8;
  const u16* vg = a.vt + (size_t)srow * T + sch * 8;
#define ATTN2_ISSUE(TT, BUF)                                                                                   \
  {                                                                                                            \
    const int tt_ = (TT) < nt ? (TT) : nt - 1;                                                                 \
    const int key0_ = tt_ < a.n0 ? a.s0 + tt_ * 64 : 2048 + (tt_ - a.n0) * 64;                                 \
    glds16(kg + (size_t)key0_ * 64, lds_base + (BUF) * 8192 + w * 1024);                                       \
    glds16(vg + key0_, lds_base + 16384 + (BUF) * 8192 + w * 1024);                                            \
  }
  __syncthreads();
  ATTN2_ISSUE(0, 0)
  ATTN2_ISSUE(1, 1)
  asm volatile("s_waitcnt vmcnt(2)" ::: "memory");
  __syncthreads();
  const int sw = (r >> 1) & 7;
  int koff[4];
#pragma unroll
  for (int ks = 0; ks < 4; ++ks) koff[ks] = r * 128 + (((2 * ks + h) ^ sw) << 4);
  for (int tt = 0; tt < nt; ++tt) {
    const char* Ks = Kb_ + (tt & 1) * 8192;
    const char* Vs = Vb_ + (tt & 1) * 8192;
    f32x16 s[2][2];
#pragma unroll
    for (int kb = 0; kb < 2; ++kb) {
#pragma unroll
      for (int q2 = 0; q2 < 2; ++q2)
#pragma unroll
        for (int i = 0; i < 16; ++i) s[q2][kb][i] = 0.f;
#pragma unroll
      for (int ks = 0; ks < 4; ++ks) {
        const bf8 kf = *(const bf8*)(Ks + kb * 32 * 128 + koff[ks]);
#pragma unroll
        for (int q2 = 0; q2 < 2; ++q2) s[q2][kb] = mfma32(kf, qf[q2][ks], s[q2][kb]);
      }
    }
    constexpr float SC = 0.125f * LOG2E;
#pragma unroll
    for (int q2 = 0; q2 < 2; ++q2) {
      float mx = -INFINITY;
#pragma unroll
      for (int kb = 0; kb < 2; ++kb)
#pragma unroll
        for (int i = 0; i < 16; i += 2) mx = fmaxf(fmaxf(mx, s[q2][kb][i]), s[q2][kb][i + 1]);
      mx = fmaxf(mx, shx(mx, lane, 32)) * SC;
      const float mn = fmaxf(m[q2], mx);
      const bool resc = __builtin_amdgcn_ballot_w64(mn != m[q2]) != 0ull;
      float ps0 = 0.f, ps1 = 0.f;
#pragma unroll
      for (int kb = 0; kb < 2; ++kb)
#pragma unroll
        for (int i = 0; i < 16; i += 2) {
          f32x2n v = {s[q2][kb][i], s[q2][kb][i + 1]};
          v = v * f32x2n{SC, SC} - f32x2n{mn, mn};
          const float p0 = ex2(v.x), p1 = ex2(v.y);
          s[q2][kb][i] = p0; s[q2][kb][i + 1] = p1;
          ps0 += p0; ps1 += p1;
        }
      if (resc) {
        const float alpha = ex2(m[q2] - mn);
        m[q2] = mn;
        lsum[q2] *= alpha;
#pragma unroll
        for (int d = 0; d < 2; ++d)
#pragma unroll
          for (int i = 0; i < 16; ++i) O[q2][d][i] *= alpha;
      }
      lsum[q2] += ps0 + ps1;
    }
#pragma unroll
    for (int kb = 0; kb < 2; ++kb)
#pragma unroll
      for (int s2 = 0; s2 < 2; ++s2) {
        const int kk = kb * 2 + s2;
        bf8 pf[2];
#pragma unroll
        for (int q2 = 0; q2 < 2; ++q2) {
          u32x4 pk;
          pk.x = pack2(s[q2][kb][s2 * 8 + 0], s[q2][kb][s2 * 8 + 1]);
          pk.y = pack2(s[q2][kb][s2 * 8 + 2], s[q2][kb][s2 * 8 + 3]);
          pk.z = pack2(s[q2][kb][s2 * 8 + 4], s[q2][kb][s2 * 8 + 5]);
          pk.w = pack2(s[q2][kb][s2 * 8 + 6], s[q2][kb][s2 * 8 + 7]);
          pf[q2] = __builtin_bit_cast(bf8, pk);
        }
#pragma unroll
        for (int d = 0; d < 2; ++d) {
          const char* vrow = Vs + (d * 32 + r) * 128 + 8 * h;
          u32x4 vv;
          const u32x2 lo = *(const u32x2*)(vrow + (((2 * kk) ^ sw) << 4));
          const u32x2 hi = *(const u32x2*)(vrow + (((2 * kk + 1) ^ sw) << 4));
          vv.x = lo.x; vv.y = lo.y; vv.z = hi.x; vv.w = hi.y;
          const bf8 vf = __builtin_bit_cast(bf8, vv);
#pragma unroll
          for (int q2 = 0; q2 < 2; ++q2) O[q2][d] = mfma32(vf, pf[q2], O[q2][d]);
        }
      }
    asm volatile("s_waitcnt vmcnt(0)" ::: "memory");
    __syncthreads();
    if (tt + 2 < nt) ATTN2_ISSUE(tt + 2, tt & 1)
  }
#pragma unroll
  for (int q2 = 0; q2 < 2; ++q2) {
    const float ltot = lsum[q2] + shx(lsum[q2], lane, 32);
    const float inv = 1.f / ltot;
#pragma unroll
    for (int d = 0; d < 2; ++d)
#pragma unroll
      for (int ig = 0; ig < 4; ++ig) {
        u32x2 o;
        o.x = pack2(O[q2][d][ig * 4 + 0] * inv, O[q2][d][ig * 4 + 1] * inv);
        o.y = pack2(O[q2][d][ig * 4 + 2] * inv, O[q2][d][ig * 4 + 3] * inv);
        *(u32x2*)(qp[q2] + d * 32 + ig * 8 + h * 4) = o;
      }
  }
}

DI void phase_attn(const Params& p, int l, char* smem) {
  u16* QO = (u16*)(p.ws + OFF_QO);
  const u16* Kb = (const u16*)(p.ws + OFF_K);
  const u16* VT = (const u16*)(p.ws + OFF_VT);
  const bool need_ctx = l < 3;
  if (l & 1) {
    const int total = 1024 + (need_ctx ? 256 : 0);
    for (int id = bid(); id < total; id += gridDim.x) {
      AttnArgs a;
      a.k2 = nullptr; a.rpb = nullptr; a.rq0 = 0; a.us = 0; a.lam = 0.f; a.oml = 0.f; a.subln = nullptr;
      if (id < 1024) {
        const int x = id & 7, q = id >> 3, within = q & 15, g = (q >> 4) * 8 + x;
        const int b = g >> 2, kvh = g & 3, hq = kvh * 4 + (within >> 2), qb = within & 3;
        a.qo = QO + (size_t)(b * 2048 + qb * 512) * 1024 + hq * 64;
        a.k1 = Kb + ((size_t)b * 4 + kvh) * T * 64;
        a.vt = VT + ((size_t)b * 256 + kvh * 64) * T;
        a.s0 = 0; a.n0 = 32; a.n1 = 4;
        attn_item_q64(a, smem);
        continue;
      } else {
        const int id2 = id - 1024;
        const int hq = id2 & 15, b = id2 >> 4, kvh = hq >> 2;
        a.qo = QO + (size_t)(NLAT + b * 256) * 1024 + hq * 64;
        a.k1 = Kb + ((size_t)b * 4 + kvh) * T * 64;
        a.vt = VT + ((size_t)b * 256 + kvh * 64) * T;
        a.s0 = 0; a.n0 = 0; a.n1 = 4;
      }
      attn_item<64, 0>(a, smem);
    }
  } else {
    const int li = l >> 1;
    const float lam = ((const float*)(p.ws + OFF_LAM))[li];
    const float oml = 1.f - ((li == 0) ? 0.2f : 0.47071301834358393f);
    const int total = 1024 + 1024 + (need_ctx ? 128 + 128 : 0);
    for (int id = bid(); id < total; id += gridDim.x) {
      AttnArgs a;
      a.k2 = nullptr; a.rpb = nullptr; a.rq0 = 0; a.us = 0; a.lam = lam; a.oml = oml; a.subln = p.diff_subln + li * 128;
      if (id < 1024) {
        const int x = id & 7, q = id >> 3, qb = q & 15, g = (q >> 4) * 8 + x;
        const int b = g >> 2, j = g & 3;
        a.qo = QO + (size_t)(b * 2048 + qb * 128) * 1024 + 512 + j * 128;
        a.k1 = Kb + ((size_t)b * 16 + 8 + 2 * j) * T * 64;
        a.k2 = Kb + ((size_t)b * 16 + 8 + 2 * j + 1) * T * 64;
        a.vt = VT + ((size_t)b * 1024 + 512 + j * 128) * T;
        a.s0 = 0; a.n0 = 32; a.n1 = 4;
        attn_item<128, 1>(a, smem);
      } else if (id < 2048) {
        const int id2 = id - 1024;
        const int x = id2 & 7, q = id2 >> 3, pr = q & 7, g = (q >> 3) * 8 + x;
        const int b = g >> 3, hd = g & 7;
        const int r0 = 4 * pr;
        int rs0 = r0 - 4; rs0 = rs0 < 0 ? 0 : (rs0 > 24 ? 24 : rs0);
        int rs3 = r0 - 1; rs3 = rs3 < 0 ? 0 : (rs3 > 24 ? 24 : rs3);
        a.qo = QO + (size_t)(b * 2048 + r0 * 64) * 1024 + hd * 64;
        a.k1 = Kb + ((size_t)b * 16 + hd) * T * 64;
        a.vt = VT + ((size_t)b * 1024 + hd * 64) * T;
        a.s0 = rs0 * 64; a.n0 = rs3 + 8 - rs0; a.n1 = 4;
        a.rpb = p.na_rpb + ((size_t)li * 8 + hd) * 15 * 31;
        a.rq0 = r0; a.us = rs0;
        attn_item<64, 2>(a, smem);
      } else if (id < 2048 + 128) {
        const int g = id - 2048, b = g >> 3, hd = g & 7;
        a.qo = QO + (size_t)(NLAT + b * 256) * 1024 + hd * 64;
        a.k1 = Kb + ((size_t)b * 16 + hd) * T * 64;
        a.vt = VT + ((size_t)b * 1024 + hd * 64) * T;
        a.s0 = 0; a.n0 = 0; a.n1 = 4;
        attn_item<64, 0>(a, smem);
      } else {
        const int id2 = id - 2048 - 128;
        const int qb = id2 & 1, g = id2 >> 1, b = g >> 2, j = g & 3;
        a.qo = QO + (size_t)(NLAT + b * 256 + qb * 128) * 1024 + 512 + j * 128;
        a.k1 = Kb + ((size_t)b * 16 + 8 + 2 * j) * T * 64;
        a.k2 = Kb + ((size_t)b * 16 + 8 + 2 * j + 1) * T * 64;
        a.vt = VT + ((size_t)b * 1024 + 512 + j * 128) * T;
        a.s0 = 0; a.n0 = 0; a.n1 = 4;
        attn_item<128, 1>(a, smem);
      }
    }
  }
}

constexpr int N_PHASES = 30;
DI void run_phase(const Params& p, int ph, char* smem) {
  if (ph == 0) {
    phase0_mods(p, smem);
    phase0_weights(p, smem, 0);
    phase0_misc(p);
    return;
  }
  if (ph == 29) { phase_final(p); return; }
  const int l = (ph - 1) / 7, s = (ph - 1) % 7;
  switch (s) {
    case 0: phase_prep(p, l, 0); break;
    case 1: phase_qkv(p, l, smem); break;
    case 2: phase_attn(p, l, smem); break;
    case 3: phase_res(p, l, 0, smem); break;
    case 4: phase_prep(p, l, 1); break;
    case 5: phase_up(p, l, smem); break;
    default: phase_res(p, l, 1, smem); break;
  }
}

#if MK_MULTI
__global__ void __launch_bounds__(512, 2) fwd_megakernel(Params p, int ph_lo, int ph_hi) {
  __shared__ __attribute__((aligned(16))) char smem[SMEM_BYTES];
  for (int ph = ph_lo; ph < ph_hi; ++ph) run_phase(p, ph, smem);
}
#else
#if USE_XCD_BARRIER
#define GRID_BARRIER() xcd_barrier(xb)
#else
#define GRID_BARRIER() grid.sync()
#endif
__global__ void __launch_bounds__(512, 2) fwd_megakernel(Params p, int ph_lo, int ph_hi) {
  __shared__ __attribute__((aligned(16))) char smem[SMEM_BYTES];
  __shared__ __attribute__((aligned(16))) unsigned xb_words[4];
  cg::grid_group grid = cg::this_grid();
  if (threadIdx.x < 4) xb_words[threadIdx.x] = 0u;
  __syncthreads();
  const XcdBarrier xb = xcd_barrier_post((unsigned*)(p.ws + OFF_BAR), (volatile LAS unsigned*)xb_words);
  phase0_mods(p, smem);
  phase0_weights(p, smem, 0);
  phase0_misc(p);
  grid.sync();
#pragma unroll 1
  for (int l = 0; l < 4; ++l) {
    phase_prep(p, l, 0);
    GRID_BARRIER();
#if PROBE == 1
    phase_qkv(p, l, smem);
    GRID_BARRIER();
    phase_attn(p, l, smem);
    GRID_BARRIER();
#endif
#if PROBE == 2
    phase_qkv(p, l, smem);
    GRID_BARRIER();
#endif
#if PROBE == 4
    phase_qkv_null(p, l, smem);
    GRID_BARRIER();
#endif
#if PROBE == 5
    GRID_BARRIER(); GRID_BARRIER(); GRID_BARRIER(); GRID_BARRIER(); GRID_BARRIER(); GRID_BARRIER(); GRID_BARRIER();
#endif
    phase_qkv(p, l, smem);
    GRID_BARRIER();
    if (l == 0 && (bid() & 1)) phase0_weights(p, smem, 1);
    phase_attn(p, l, smem);
    if (l == 0 && !(bid() & 1)) phase0_weights(p, smem, 1);
    GRID_BARRIER();
    phase_res(p, l, 0, smem);
    GRID_BARRIER();
    phase_prep(p, l, 1);
    GRID_BARRIER();
#if PROBE == 3
    phase_up(p, l, smem);
    GRID_BARRIER();
#endif
    phase_up(p, l, smem);
    GRID_BARRIER();
    phase_res(p, l, 1, smem);
    GRID_BARRIER();
  }
  phase_final(p);
}
#endif

extern "C" void kernel_launch(void* const* d_in, const int* in_sizes, int n_in, void* d_out, int out_size, void* d_ws, size_t ws_size,
                              hipStream_t stream) {
  static int grid_blocks = 0;
  if (!grid_blocks) {
    int dev = 0, cus = 0, per_cu = 0;
    hipGetDevice(&dev);
    hipDeviceGetAttribute(&cus, hipDeviceAttributeMultiprocessorCount, dev);
    hipOccupancyMaxActiveBlocksPerMultiprocessor(&per_cu, fwd_megakernel, NTHR, 0);
    per_cu = 1;
    grid_blocks = cus * per_cu;
  }
  if (ws_size < WS_NEEDED) fprintf(stderr, "workspace too small: %zu < %zu\n", ws_size, (size_t)WS_NEEDED);
  Params p{};
  p.x = (const float*)d_in[0]; p.c = (const float*)d_in[1]; p.ctx = (const float*)d_in[2]; p.c_ctx = (const float*)d_in[3];
  p.w_ada = (const float*)d_in[4]; p.b_ada = (const float*)d_in[5]; p.ln_g = (const float*)d_in[6]; p.ln_b = (const float*)d_in[7];
  p.w_in_ab = (const float*)d_in[8]; p.w_o_ab = (const float*)d_in[9]; p.na_rpb = (const float*)d_in[10];
  p.diff_lambda = (const float*)d_in[11]; p.diff_subln = (const float*)d_in[12]; p.w_in_c = (const float*)d_in[13];
  p.w_o_c = (const float*)d_in[14]; p.gqa_qk_norm = (const float*)d_in[15]; p.w_up = (const float*)d_in[16];
  p.conv_w = (const float*)d_in[17]; p.conv_b = (const float*)d_in[18]; p.w_down = (const float*)d_in[19];
  p.out = (float*)d_out;
  p.ws = (char*)d_ws;
  hipMemsetAsync((char*)d_ws + OFF_BAR, 0, 16384, stream);
#if MK_MULTI
  for (int ph = 0; ph < N_PHASES; ++ph) {
    hipLaunchKernelGGL(fwd_megakernel, dim3(grid_blocks), dim3(NTHR), 0, stream, p, ph, ph + 1);
  }
#else
  int lo = 0, hi = N_PHASES;
  void* args[] = {&p, &lo, &hi};
  hipError_t e = hipLaunchCooperativeKernel((void*)fwd_megakernel, dim3(grid_blocks), dim3(NTHR), args, 0, stream);
  if (e != hipSuccess) fprintf(stderr, "cooperative launch failed: %s (grid %d)\n", hipGetErrorString(e), grid_blocks);
#endif
}
```

```cpp
#include <hip/hip_runtime.h>
#include <hip/hip_cooperative_groups.h>
#include <cstdio>
namespace cg = cooperative_groups;

#ifndef PROBE
#define PROBE 0
#endif
#ifndef USE_XCD_BARRIER
#define USE_XCD_BARRIER 1
#endif
#ifndef MK_MULTI
#define MK_MULTI 0
#endif

#define DI __device__ __forceinline__
typedef unsigned short u16;
typedef __attribute__((ext_vector_type(8))) __bf16 bf8;
typedef __attribute__((ext_vector_type(2))) __bf16 bf2;
typedef __attribute__((ext_vector_type(2))) float f2;
typedef __attribute__((ext_vector_type(16))) float f32x16;
typedef __attribute__((ext_vector_type(4))) _Float16 h4;
typedef __attribute__((ext_vector_type(8))) _Float16 h8;
typedef __attribute__((ext_vector_type(4))) unsigned u32x4;
typedef __attribute__((ext_vector_type(2))) unsigned u32x2;
typedef __attribute__((ext_vector_type(4))) float f32x4n;
typedef __attribute__((ext_vector_type(2))) float f32x2n;

constexpr int NLAT = 32768, NCTX = 4096, NROWS = 36864, T = 2304, DFF = 2816;
constexpr float ALPHA = 1.681792830507429f;
constexpr float EPS = 1e-6f;
constexpr float LOG2E = 1.4426950408889634f;

constexpr size_t OFF_MODS = 0;
constexpr size_t OFF_ROPE = OFF_MODS + 1671168;
constexpr size_t OFF_LAM = OFF_ROPE + 8192;
constexpr size_t OFF_WIN_E = OFF_LAM + 256;
constexpr size_t OFF_WIN_O = OFF_WIN_E + 12582912;
constexpr size_t OFF_WO = OFF_WIN_O + 6291456;
constexpr size_t OFF_WUP = OFF_WO + 8388608;
constexpr size_t OFF_WD = OFF_WUP + 46137344;
constexpr size_t OFF_X = OFF_WD + 23068672;
constexpr size_t OFF_H = OFF_X + 75497472;
constexpr size_t OFF_QO = OFF_H + 75497472;
constexpr size_t OFF_K = OFF_QO + 75497472;
constexpr size_t OFF_VT = OFF_K + 75497472;
constexpr size_t OFF_END = OFF_VT + 75497472;
constexpr size_t OFF_ACT = OFF_QO;
constexpr size_t OFF_BAR = OFF_END;
constexpr size_t WS_NEEDED = OFF_BAR + 16384;

constexpr int SMEM_BYTES = 131072 + 4096;
constexpr int NTHR = 512, NWAVE = 8;

struct Params {
  const float *x, *c, *ctx, *c_ctx, *w_ada, *b_ada, *ln_g, *ln_b, *w_in_ab, *w_o_ab, *na_rpb, *diff_lambda, *diff_subln,
      *w_in_c, *w_o_c, *gqa_qk_norm, *w_up, *conv_w, *conv_b, *w_down;
  float* out;
  char* ws;
};

DI unsigned pack2(float a, float b) { f2 v = {a, b}; bf2 r = __builtin_convertvector(v, bf2); return __builtin_bit_cast(unsigned, r); }
DI u16 f2bf(float a) { __bf16 b = (__bf16)a; return __builtin_bit_cast(u16, b); }
DI int crow(int i, int h) { return (i & 3) + 8 * (i >> 2) + 4 * h; }
DI f32x16 mfma32(bf8 a, bf8 b, f32x16 c) { return __builtin_amdgcn_mfma_f32_32x32x16_bf16(a, b, c, 0, 0, 0); }
DI int tid() { int t; asm volatile("v_mov_b32 %0, %1" : "=v"(t) : "v"((int)threadIdx.x)); return t; }
DI int bid() { int b; asm volatile("s_mov_b32 %0, %1" : "=s"(b) : "s"((int)blockIdx.x)); return b; }
typedef __attribute__((address_space(3))) char lds_char;
DI void glds16(const void* gptr, unsigned lds_addr) {
  asm volatile("s_mov_b32 m0, %0\n\ts_nop 0\n\tglobal_load_lds_dwordx4 %1, off" ::"s"(lds_addr), "v"(gptr) : "memory");
}
DI float ex2(float x) { return __builtin_amdgcn_exp2f(x); }
DI float shx(float v, int lane, int mask) { return __int_as_float(__builtin_amdgcn_ds_bpermute((lane ^ mask) << 2, __float_as_int(v))); }
DI float shi(float v, int src) { return __int_as_float(__builtin_amdgcn_ds_bpermute(src << 2, __float_as_int(v))); }
DI float wave_sum(float v, int lane) {
#pragma unroll
  for (int o = 1; o < 64; o <<= 1) v += shx(v, lane, o);
  return v;
}

#define XB_TMO      128
#define XB_XCNT(j)  (256  + 64 * (j))
#define XB_XSUB(j)  (1280 + 64 * (j))
#define XB_XGEN(j)  (2304 + 64 * (j))
#define XB_TOP      3328
#define XB_TOPGEN   3392
#define XCD_BAR_WORDS 3456
#define XB_SPIN_CAP (1u << 18)
#define LAS __attribute__((address_space(3)))
DI unsigned xb_ld(unsigned* p) { return __hip_atomic_load(p, __ATOMIC_RELAXED, __HIP_MEMORY_SCOPE_AGENT); }
DI unsigned xb_add(unsigned* p, unsigned v) { return __hip_atomic_fetch_add(p, v, __ATOMIC_RELAXED, __HIP_MEMORY_SCOPE_AGENT); }
DI unsigned xb_xcc_id() { return (unsigned)__builtin_amdgcn_s_getreg((3 << 11) | 20) & 0xFu; }
#define XB_SPIN(cond, bar) do { unsigned _sp = 0; while (cond) { __builtin_amdgcn_s_sleep(1); \
    if ((++_sp & 255u) == 0u) { if (xb_ld(&(bar)[XB_TMO])) break; if (_sp > XB_SPIN_CAP) { atomicAdd(&(bar)[XB_TMO], 1u); break; } } } } while (0)
struct XcdBarrier { unsigned* bar; unsigned x; volatile LAS unsigned* st; };
DI XcdBarrier xcd_barrier_post(unsigned* bar, volatile LAS unsigned* st) {
  XcdBarrier b; b.bar = bar; b.x = xb_xcc_id(); b.st = st;
  if (threadIdx.x == 0) (void)xb_add(&bar[XB_XCNT(b.x)], 1u);
  return b;
}
DI void xcd_barrier_complete(unsigned* bar, unsigned x, unsigned& nloc, unsigned& nx) {
  const unsigned G = gridDim.x * gridDim.y * gridDim.z;
  unsigned sum, cnt, mine, sp = 0u;
  for (;;) {
    sum = 0u; cnt = 0u; mine = 0u;
#pragma unroll
    for (unsigned j = 0; j < 16; ++j) { const unsigned c = xb_ld(&bar[XB_XCNT(j)]); sum += c; cnt += (c > 0u) ? 1u : 0u; mine = (j == x) ? c : mine; }
    if (sum == G) break;
    __builtin_amdgcn_s_sleep(1);
    if ((++sp & 255u) == 0u) { if (xb_ld(&bar[XB_TMO])) break; if (sp > XB_SPIN_CAP) { atomicAdd(&bar[XB_TMO], 1u); break; } }
  }
  nloc = mine > 0u ? mine : 1u; nx = cnt > 0u ? cnt : 1u;
}
DI void xcd_barrier(const XcdBarrier& b) {
  asm volatile("s_waitcnt vmcnt(0)" ::: "memory");
  __syncthreads();
  if (threadIdx.x == 0) {
    unsigned* bar = b.bar;
    __builtin_amdgcn_s_waitcnt(0);
    unsigned nloc = b.st[0], nx = b.st[1];
    if (nloc == 0u) { xcd_barrier_complete(bar, b.x, nloc, nx); b.st[0] = nloc; b.st[1] = nx; }
    const unsigned old = xb_add(&bar[XB_XSUB(b.x)], 1u);
    const unsigned gen = old / nloc;
    if (old + 1u == (gen + 1u) * nloc) {
      __builtin_amdgcn_fence(__ATOMIC_RELEASE, "agent");
      asm volatile("s_waitcnt vmcnt(0)" ::: "memory");
      const unsigned og = xb_add(&bar[XB_TOP], 1u);
      const unsigned tg = og / nx;
      if (og + 1u == (tg + 1u) * nx) xb_add(&bar[XB_TOPGEN], 1u);
      else XB_SPIN(xb_ld(&bar[XB_TOPGEN]) == tg, bar);
      __builtin_amdgcn_fence(__ATOMIC_ACQUIRE, "agent");
      xb_add(&bar[XB_XGEN(b.x)], 1u);
      asm volatile("s_waitcnt vmcnt(0)" ::: "memory");
    } else {
      XB_SPIN(xb_ld(&bar[XB_XGEN(b.x)]) == gen, bar);
      __builtin_amdgcn_fence(__ATOMIC_ACQUIRE, "agent");
      asm volatile("s_waitcnt vmcnt(0)" ::: "memory");
    }
  }
  __syncthreads();
}

DI void phase0_mods(const Params& p, char* smem) {
  float* condS = (float*)smem;
  float* red = (float*)(smem + 17 * 512 * 4);
  float* mods = (float*)(p.ws + OFF_MODS);
  const int t = tid(), lane = t & 63, w = __builtin_amdgcn_readfirstlane(t >> 6);
  const int cq = t & 15, kg = t >> 4;
  for (int item = bid(); item < 4 * 96; item += gridDim.x) {
    const int l = item / 96, cb = item % 96;
    const int col = cb * 64 + cq * 4;
    float acc[17][4];
#pragma unroll
    for (int i = 0; i < 17; ++i) { acc[i][0] = 0.f; acc[i][1] = 0.f; acc[i][2] = 0.f; acc[i][3] = 0.f; }
    for (int kh = 0; kh < 2; ++kh) {
      __syncthreads();
      for (int e = t; e < 17 * 512; e += NTHR) {
        const int i = e >> 9, k = (e & 511) + kh * 512;
        const float v = (i < 16) ? p.c[i * 1024 + k] : p.c_ctx[k];
        condS[e] = v / (1.f + __expf(-v));
      }
      __syncthreads();
      const float* wp = p.w_ada + ((size_t)l * 1024 + kh * 512 + kg * 16) * 6144 + col;
#pragma unroll 2
      for (int kk = 0; kk < 16; ++kk) {
        const f32x4n wv = *(const f32x4n*)(wp + (size_t)kk * 6144);
#pragma unroll
        for (int i = 0; i < 17; ++i) {
          const float cv = condS[i * 512 + kg * 16 + kk];
          acc[i][0] += cv * wv.x; acc[i][1] += cv * wv.y; acc[i][2] += cv * wv.z; acc[i][3] += cv * wv.w;
        }
      }
    }
#pragma unroll
    for (int i = 0; i < 17; ++i)
#pragma unroll
      for (int j = 0; j < 4; ++j) {
        float v = acc[i][j];
        v += shx(v, lane, 16);
        v += shx(v, lane, 32);
        acc[i][j] = v;
      }
    __syncthreads();
    if (lane < 16) {
#pragma unroll
      for (int i = 0; i < 17; ++i)
#pragma unroll
        for (int j = 0; j < 4; ++j) red[(w * 17 + i) * 64 + cq * 4 + j] = acc[i][j];
    }
    __syncthreads();
    for (int e = t; e < 17 * 64; e += NTHR) {
      const int i = e >> 6, cc = e & 63;
      float s = 0.f;
#pragma unroll
      for (int ww = 0; ww < NWAVE; ++ww) s += red[(ww * 17 + i) * 64 + cc];
      mods[(size_t)(l * 17 + i) * 6144 + cb * 64 + cc] = s + p.b_ada[l * 6144 + cb * 64 + cc];
    }
  }
}

DI void transpose_tile(const float* __restrict__ src, int ldsrc, int k0, int c0, int c1, u16* __restrict__ dst, int lddst, int p0, float* tileS) {
  const int t = tid();
  __syncthreads();
  {
    const int n = t & 63;
    const int col = (n < 32) ? (c0 + n) : (c1 + n - 32);
#pragma unroll
    for (int j = 0; j < 8; ++j) {
      const int kk = (t >> 6) + 8 * j;
      tileS[kk * 65 + n] = src[(size_t)(k0 + kk) * ldsrc + col];
    }
  }
  __syncthreads();
  {
    const int kk2 = (t & 7) * 8;
    const int n2 = t >> 3;
    u32x4 o;
    o.x = pack2(tileS[(kk2 + 0) * 65 + n2], tileS[(kk2 + 1) * 65 + n2]);
    o.y = pack2(tileS[(kk2 + 2) * 65 + n2], tileS[(kk2 + 3) * 65 + n2]);
    o.z = pack2(tileS[(kk2 + 4) * 65 + n2], tileS[(kk2 + 5) * 65 + n2]);
    o.w = pack2(tileS[(kk2 + 6) * 65 + n2], tileS[(kk2 + 7) * 65 + n2]);
    *(u32x4*)(dst + (size_t)(p0 + n2) * lddst + k0 + kk2) = o;
  }
}

DI void phase0_weights(const Params& p, char* smem, int sel) {
  float* tileS = (float*)smem;
  for (int item = bid(); item < 11776; item += gridDim.x) {
    int it = item;
    if (it < 1536) {
      const int i = it / 768, r = it % 768, kt = r / 48, nt = r % 48;
      if ((i == 0) != (sel == 0)) continue;
      transpose_tile(p.w_in_ab + (size_t)i * 1024 * 3072, 3072, kt * 64, nt * 64, nt * 64 + 32,
                     (u16*)(p.ws + OFF_WIN_E) + (size_t)i * 3072 * 1024, 1024, nt * 64, tileS);
      continue;
    }
    it -= 1536;
    if (it < 768) {
      const int i = it / 384, r = it % 384, kt = r / 24, nt = r % 24;
      if (sel == 0) continue;
      transpose_tile(p.w_in_c + (size_t)i * 1024 * 1536, 1536, kt * 64, nt * 64, nt * 64 + 32,
                     (u16*)(p.ws + OFF_WIN_O) + (size_t)i * 1536 * 1024, 1024, nt * 64, tileS);
      continue;
    }
    it -= 768;
    if (it < 1024) {
      const int l = it / 256, r = it % 256, kt = r / 16, nt = r % 16;
      if ((l == 0) != (sel == 0)) continue;
      const float* src = ((l & 1) ? p.w_o_c : p.w_o_ab) + (size_t)(l >> 1) * 1024 * 1024;
      transpose_tile(src, 1024, kt * 64, nt * 64, nt * 64 + 32, (u16*)(p.ws + OFF_WO) + (size_t)l * 1024 * 1024, 1024, nt * 64, tileS);
      continue;
    }
    it -= 1024;
    if (it < 5632) {
      const int l = it / 1408, r = it % 1408, kt = r / 88, pt = r % 88;
      if ((l == 0) != (sel == 0)) continue;
      const int ntile = pt >> 2, wn = pt & 3;
      const int c0 = ntile * 128 + wn * 32;
      transpose_tile(p.w_up + (size_t)l * 1024 * 5632, 5632, kt * 64, c0, c0 + 2816,
                     (u16*)(p.ws + OFF_WUP) + (size_t)l * 5632 * 1024, 1024, pt * 64, tileS);
      continue;
    }
    it -= 5632;
    {
      const int l = it / 704, r = it % 704, kt = r / 16, nt = r % 16;
      if ((l == 0) != (sel == 0)) continue;
      transpose_tile(p.w_down + (size_t)l * 2816 * 1024, 1024, kt * 64, nt * 64, nt * 64 + 32,
                     (u16*)(p.ws + OFF_WD) + (size_t)l * 1024 * 2816, 2816, nt * 64, tileS);
    }
  }
}

DI void phase0_misc(const Params& p) {
  if (bid() != 0) return;
  const int t = tid();
  f32x2n* rope = (f32x2n*)(p.ws + OFF_ROPE);
  for (int e = t; e < 1024; e += NTHR) {
    const int pos = e >> 4, f = e & 15;
    const float inv = ex2(-(float)f * 0.8304820237218406f);
    const float ang = (float)pos * inv;
    rope[e] = f32x2n{__cosf(ang), __sinf(ang)};
  }
  if (t < 2) {
    const float* lv = p.diff_lambda + t * 256;
    float s1 = 0.f, s2 = 0.f;
    for (int k = 0; k < 64; ++k) { s1 += lv[k] * lv[64 + k]; s2 += lv[128 + k] * lv[192 + k]; }
    const float li = (t == 0) ? 0.2f : 0.47071301834358393f;
    ((float*)(p.ws + OFF_LAM))[t] = __expf(s1) - __expf(s2) + li;
  }
}

DI void phase_prep(const Params& p, int l, int which) {
  const int t = tid(), lane = t & 63, w = __builtin_amdgcn_readfirstlane(t >> 6);
  const int rows = (which == 1 && l == 3) ? NLAT : NROWS;
  const bool raw = (which == 0 && l == 0);
  const float* mods = (const float*)(p.ws + OFF_MODS);
  const float* g = raw ? nullptr : (which == 0 ? p.ln_g + ((l - 1) * 2 + 1) * 1024 : p.ln_g + (l * 2) * 1024);
  const float* bb = raw ? nullptr : (which == 0 ? p.ln_b + ((l - 1) * 2 + 1) * 1024 : p.ln_b + (l * 2) * 1024);
  _Float16* X = (_Float16*)(p.ws + OFF_X);
  u16* H = (u16*)(p.ws + OFF_H);
  constexpr int NR = 2;
  const int nwv = gridDim.x * NWAVE;
  for (int Rb = bid() * NWAVE + w; Rb < rows; Rb += nwv * NR) {
    float v[NR][16];
    int RR[NR];
#pragma unroll
    for (int u = 0; u < NR; ++u) {
      const int R0 = Rb + u * nwv;
      RR[u] = R0 < rows ? R0 : Rb;
    }
    if (raw) {
#pragma unroll
      for (int u = 0; u < NR; ++u) {
        const int R = RR[u];
        const float* src = (R < NLAT) ? p.x + (size_t)R * 1024 : p.ctx + (size_t)(R - NLAT) * 1024;
#pragma unroll
        for (int q = 0; q < 2; ++q) {
          const f32x4n a = *(const f32x4n*)(src + q * 512 + lane * 8);
          const f32x4n b = *(const f32x4n*)(src + q * 512 + lane * 8 + 4);
          v[u][q * 8 + 0] = a.x; v[u][q * 8 + 1] = a.y; v[u][q * 8 + 2] = a.z; v[u][q * 8 + 3] = a.w;
          v[u][q * 8 + 4] = b.x; v[u][q * 8 + 5] = b.y; v[u][q * 8 + 6] = b.z; v[u][q * 8 + 7] = b.w;
        }
      }
    } else {
#pragma unroll
      for (int u = 0; u < NR; ++u)
#pragma unroll
        for (int q = 0; q < 2; ++q) {
          const h8 a = *(const h8*)(X + (size_t)RR[u] * 1024 + q * 512 + lane * 8);
#pragma unroll
          for (int j = 0; j < 8; ++j) v[u][q * 8 + j] = (float)a[j];
        }
      float s[NR], mean[NR], s2[NR], rstd[NR];
#pragma unroll
      for (int u = 0; u < NR; ++u) {
        s[u] = 0.f;
#pragma unroll
        for (int j = 0; j < 16; ++j) s[u] += v[u][j];
      }
#pragma unroll
      for (int o = 1; o < 64; o <<= 1)
#pragma unroll
        for (int u = 0; u < NR; ++u) s[u] += shx(s[u], lane, o);
#pragma unroll
      for (int u = 0; u < NR; ++u) {
        mean[u] = s[u] * (1.f / 1024.f);
        s2[u] = 0.f;
#pragma unroll
        for (int j = 0; j < 16; ++j) { const float d = v[u][j] - mean[u]; s2[u] += d * d; }
      }
#pragma unroll
      for (int o = 1; o < 64; o <<= 1)
#pragma unroll
        for (int u = 0; u < NR; ++u) s2[u] += shx(s2[u], lane, o);
#pragma unroll
      for (int u = 0; u < NR; ++u) rstd[u] = rsqrtf(s2[u] * (1.f / 1024.f) + EPS);
#pragma unroll
      for (int q = 0; q < 2; ++q) {
        const int c = q * 512 + lane * 8;
        const f32x4n g0 = *(const f32x4n*)(g + c), g1 = *(const f32x4n*)(g + c + 4);
        const f32x4n b0 = *(const f32x4n*)(bb + c), b1 = *(const f32x4n*)(bb + c + 4);
        const float gg[8] = {g0.x, g0.y, g0.z, g0.w, g1.x, g1.y, g1.z, g1.w};
        const float bv[8] = {b0.x, b0.y, b0.z, b0.w, b1.x, b1.y, b1.z, b1.w};
#pragma unroll
        for (int u = 0; u < NR; ++u)
#pragma unroll
          for (int j = 0; j < 8; ++j) v[u][q * 8 + j] = (v[u][q * 8 + j] - mean[u]) * rstd[u] * gg[j] + bv[j];
      }
    }
#pragma unroll
    for (int u = 0; u < NR; ++u) {
      const int R = RR[u];
      const int mi = (R < NLAT) ? (R >> 11) : 16;
      const float* md = mods + (size_t)(l * 17 + mi) * 6144 + (which == 0 ? 0 : 3 * 1024);
#pragma unroll
      for (int q = 0; q < 2; ++q) {
        const int c = q * 512 + lane * 8;
        h8 xo;
#pragma unroll
        for (int j = 0; j < 8; ++j) xo[j] = (_Float16)v[u][q * 8 + j];
        *(h8*)(X + (size_t)R * 1024 + c) = xo;
        const f32x4n s0 = *(const f32x4n*)(md + c), s1 = *(const f32x4n*)(md + c + 4);
        const f32x4n c0 = *(const f32x4n*)(md + 1024 + c), c1 = *(const f32x4n*)(md + 1024 + c + 4);
        const float sh[8] = {s0.x, s0.y, s0.z, s0.w, s1.x, s1.y, s1.z, s1.w};
        const float sc[8] = {c0.x, c0.y, c0.z, c0.w, c1.x, c1.y, c1.z, c1.w};
        float hv[8];
#pragma unroll
        for (int j = 0; j < 8; ++j) hv[j] = v[u][q * 8 + j] * (1.f + sc[j]) + sh[j];
        u32x4 o;
        o.x = pack2(hv[0], hv[1]); o.y = pack2(hv[2], hv[3]); o.z = pack2(hv[4], hv[5]); o.w = pack2(hv[6], hv[7]);
        *(u32x4*)(H + (size_t)R * 1024 + c) = o;
      }
    }
  }
}

DI void phase_final(const Params& p) {
  const int t = tid(), lane = t & 63, w = __builtin_amdgcn_readfirstlane(t >> 6);
  const float* g = p.ln_g + (3 * 2 + 1) * 1024;
  const float* bb = p.ln_b + (3 * 2 + 1) * 1024;
  const _Float16* X = (const _Float16*)(p.ws + OFF_X);
  constexpr int NR = 2;
  const int nwv = gridDim.x * NWAVE;
  for (int Rb = bid() * NWAVE + w; Rb < NLAT; Rb += nwv * NR) {
    float v[NR][16];
    int RR[NR];
#pragma unroll
    for (int u = 0; u < NR; ++u) { const int R0 = Rb + u * nwv; RR[u] = R0 < NLAT ? R0 : Rb; }
#pragma unroll
    for (int u = 0; u < NR; ++u)
#pragma unroll
      for (int q = 0; q < 2; ++q) {
        const h8 a = *(const h8*)(X + (size_t)RR[u] * 1024 + q * 512 + lane * 8);
#pragma unroll
        for (int j = 0; j < 8; ++j) v[u][q * 8 + j] = (float)a[j];
      }
    float s[NR], mean[NR], s2[NR], rstd[NR];
#pragma unroll
    for (int u = 0; u < NR; ++u) {
      s[u] = 0.f;
#pragma unroll
      for (int j = 0; j < 16; ++j) s[u] += v[u][j];
    }
#pragma unroll
    for (int o = 1; o < 64; o <<= 1)
#pragma unroll
      for (int u = 0; u < NR; ++u) s[u] += shx(s[u], lane, o);
#pragma unroll
    for (int u = 0; u < NR; ++u) {
      mean[u] = s[u] * (1.f / 1024.f);
      s2[u] = 0.f;
#pragma unroll
      for (int j = 0; j < 16; ++j) { const float d = v[u][j] - mean[u]; s2[u] += d * d; }
    }
#pragma unroll
    for (int o = 1; o < 64; o <<= 1)
#pragma unroll
      for (int u = 0; u < NR; ++u) s2[u] += shx(s2[u], lane, o);
#pragma unroll
    for (int u = 0; u < NR; ++u) rstd[u] = rsqrtf(s2[u] * (1.f / 1024.f) + EPS);
#pragma unroll
    for (int q = 0; q < 2; ++q) {
      const int c = q * 512 + lane * 8;
      const f32x4n g0 = *(const f32x4n*)(g + c), g1 = *(const f32x4n*)(g + c + 4);
      const f32x4n b0 = *(const f32x4n*)(bb + c), b1 = *(const f32x4n*)(bb + c + 4);
#pragma unroll
      for (int u = 0; u < NR; ++u) {
        f32x4n o0, o1;
        o0.x = (v[u][q * 8 + 0] - mean[u]) * rstd[u] * g0.x + b0.x; o0.y = (v[u][q * 8 + 1] - mean[u]) * rstd[u] * g0.y + b0.y;
        o0.z = (v[u][q * 8 + 2] - mean[u]) * rstd[u] * g0.z + b0.z; o0.w = (v[u][q * 8 + 3] - mean[u]) * rstd[u] * g0.w + b0.w;
        o1.x = (v[u][q * 8 + 4] - mean[u]) * rstd[u] * g1.x + b1.x; o1.y = (v[u][q * 8 + 5] - mean[u]) * rstd[u] * g1.y + b1.y;
        o1.z = (v[u][q * 8 + 6] - mean[u]) * rstd[u] * g1.z + b1.z; o1.w = (v[u][q * 8 + 7] - mean[u]) * rstd[u] * g1.w + b1.w;
        *(f32x4n*)(p.out + (size_t)RR[u] * 1024 + c) = o0;
        *(f32x4n*)(p.out + (size_t)RR[u] * 1024 + c + 4) = o1;
      }
    }
  }
}

template <int MB, class Epi>
DI void gemm_tile(const u16* __restrict__ A, int lda, int row0, int Mrows, const u16* __restrict__ Bt, int ldb, int K, char* smem, Epi& epi, int rot) {
  char* As = smem;
  char* Bs = smem + 65536;
  const unsigned lds_base = (unsigned)(size_t)(lds_char*)smem;
  const int t = tid(), lane = t & 63, w = __builtin_amdgcn_readfirstlane(t >> 6), wm = w >> 2, wn = w & 3, r = lane & 31, h = lane >> 5;
  constexpr int NAJ = MB;
  const int lr = t >> 3;
  const int lch = (t & 7) ^ ((lr >> 1) & 7);
  unsigned aoff[NAJ];
#pragma unroll
  for (int j = 0; j < NAJ; ++j) {
    int gr = row0 + lr + 64 * j;
    gr = gr < 0 ? 0 : (gr > Mrows - 1 ? Mrows - 1 : gr);
    aoff[j] = (unsigned)gr * (unsigned)lda + lch * 8;
  }
  const u16* bp = Bt + (size_t)lr * ldb + lch * 8;
  f32x16 acc[2][MB];
#pragma unroll
  for (int nb = 0; nb < 2; ++nb)
#pragma unroll
    for (int mb = 0; mb < MB; ++mb)
#pragma unroll
      for (int i = 0; i < 16; ++i) acc[nb][mb][i] = 0.f;
  const int KT = K >> 6;
  int kcur = rot % KT;
#define GEMM_PIECE(STG, PC)                                                                                           \
  {                                                                                                                   \
    if ((PC) < NAJ)                                                                                                   \
      glds16(A + ko_ + aoff[(PC) < NAJ ? (PC) : 0], lds_base + (STG) * 32768 + (w * 64 + 512 * (PC)) * 16);           \
    else if ((PC) < NAJ + 4)                                                                                          \
      glds16(bp + ko_ + (size_t)(64 * ((PC) - NAJ)) * ldb,                                                            \
             lds_base + 65536 + (STG) * 32768 + (w * 64 + 512 * ((PC) - NAJ)) * 16);                                  \
  }
#define GEMM_STAGE(STG)                                                                                               \
  {                                                                                                                   \
    const int ko_ = kcur * 64;                                                                                        \
    _Pragma("unroll") for (int pc = 0; pc < NAJ + 4; ++pc) GEMM_PIECE(STG, pc)                                        \
  }
  GEMM_STAGE(0)
  asm volatile("s_waitcnt vmcnt(0)" ::: "memory");
  __syncthreads();
  const int sw = (r >> 1) & 7;
  int foff[4];
#pragma unroll
  for (int ks = 0; ks < 4; ++ks) foff[ks] = r * 128 + (((2 * ks + h) ^ sw) << 4);
  bf8 af[2][MB], bfr[2][2];
  {
    const char* as0 = As + wm * (32 * MB) * 128;
    const char* bs0 = Bs + wn * 64 * 128;
#pragma unroll
    for (int mb = 0; mb < MB; ++mb) af[0][mb] = *(const bf8*)(as0 + mb * 32 * 128 + foff[0]);
#pragma unroll
    for (int nb = 0; nb < 2; ++nb) bfr[0][nb] = *(const bf8*)(bs0 + nb * 32 * 128 + foff[0]);
  }
  const int kbase = rot % KT;
  if (KT > 1) {
    const int k1_ = (kbase + 1 >= KT) ? kbase + 1 - KT : kbase + 1;
    const int ko_ = k1_ * 64;
#pragma unroll
    for (int pc = 0; pc < 3; ++pc) GEMM_PIECE(1, pc)
  }
  for (int kt = 0; kt < KT; ++kt) {
    const bool more = (kt + 1 < KT);
    const bool more2 = (kt + 2 < KT);
    const int nstg = (kt + 1) & 1;
    const char* as = As + (kt & 1) * 32768 + wm * (32 * MB) * 128;
    const char* bs = Bs + (kt & 1) * 32768 + wn * 64 * 128;
    int k1_ = kbase + kt + 1; if (k1_ >= KT) k1_ -= KT;
    int k2_ = kbase + kt + 2; if (k2_ >= KT) k2_ -= KT; if (k2_ >= KT) k2_ -= KT;
#pragma unroll
    for (int ks = 0; ks < 3; ++ks) {
#pragma unroll
      for (int idx = 0; idx < 2 * MB; ++idx) {
        const int nb = idx / MB, mb = idx % MB;
        acc[nb][mb] = mfma32(bfr[ks & 1][nb], af[ks & 1][mb], acc[nb][mb]);
        if (idx < MB) af[(ks + 1) & 1][idx] = *(const bf8*)(as + idx * 32 * 128 + foff[ks + 1]);
        else if (idx < MB + 2) bfr[(ks + 1) & 1][idx - MB] = *(const bf8*)(bs + (idx - MB) * 32 * 128 + foff[ks + 1]);
        if (more && ks < 2 && idx < 3) {
          const int ko_ = k1_ * 64;
          GEMM_PIECE(nstg, 3 + ks * 3 + idx)
        }
        __builtin_amdgcn_sched_barrier(0);
      }
    }
    if (more) {
      asm volatile("s_waitcnt vmcnt(0)" ::: "memory");
      __syncthreads();
      if (more2) {
        const int ko_ = k2_ * 64;
#pragma unroll
        for (int pc = 0; pc < 3; ++pc) GEMM_PIECE(kt & 1, pc)
      }
      __builtin_amdgcn_sched_barrier(0);
      const char* asn = As + nstg * 32768 + wm * (32 * MB) * 128;
      const char* bsn = Bs + nstg * 32768 + wn * 64 * 128;
#pragma unroll
      for (int mb = 0; mb < MB; ++mb) af[0][mb] = *(const bf8*)(asn + mb * 32 * 128 + foff[0]);
#pragma unroll
      for (int nb = 0; nb < 2; ++nb) bfr[0][nb] = *(const bf8*)(bsn + nb * 32 * 128 + foff[0]);
    }
#pragma unroll
    for (int nb = 0; nb < 2; ++nb)
#pragma unroll
      for (int mb = 0; mb < MB; ++mb) acc[nb][mb] = mfma32(bfr[1][nb], af[1][mb], acc[nb][mb]);
#pragma unroll
    for (int gk = 0; gk < 2 * MB; ++gk) {
      __builtin_amdgcn_sched_group_barrier(0x008, 1, 0);
      __builtin_amdgcn_sched_group_barrier(0x100, 1, 0);
    }
    __builtin_amdgcn_sched_barrier(0);
  }
  __syncthreads();
  epi(acc, wm, wn, r, h);
}

template <int MB>
struct EpiRes {
  _Float16* X; const float* gate; int row0, n0; u16* ostage;
  DI void operator()(f32x16 (&acc)[2][MB], int wm, int wn, int r, int h) {
    u16* slab = ostage + (wm * 4 + wn) * (64 * 72);
    const int lane = h * 32 + r;
#pragma unroll
    for (int mb = 0; mb < MB; ++mb) {
      const int tokl = (mb & 1) * 32 + r;
#pragma unroll
      for (int nb = 0; nb < 2; ++nb)
#pragma unroll
        for (int ig = 0; ig < 4; ++ig) {
          u32x2 o;
          o.x = pack2(acc[nb][mb][ig * 4 + 0], acc[nb][mb][ig * 4 + 1]);
          o.y = pack2(acc[nb][mb][ig * 4 + 2], acc[nb][mb][ig * 4 + 3]);
          *(u32x2*)(slab + tokl * 72 + nb * 32 + ig * 8 + h * 4) = o;
        }
      if ((mb & 1) || mb == MB - 1) {
        asm volatile("s_waitcnt lgkmcnt(0)" ::: "memory");
        const int ntok = (mb & 1) ? 64 : 32;
        const int R0 = row0 + wm * (32 * MB) + (mb >> 1) * 64;
#pragma unroll
        for (int j = 0; j < 8; ++j) {
          const int rowl = (lane >> 3) + 8 * j, ch = lane & 7;
          if (rowl < ntok) {
            const u32x4 yv = *(const u32x4*)(slab + rowl * 72 + ch * 8);
            const int R = R0 + rowl;
            const int mi = (R < NLAT) ? (R >> 11) : 16;
            const int col = n0 + wn * 64 + ch * 8;
            const float* g = gate + (size_t)mi * 6144 + col;
            const f32x4n g0 = *(const f32x4n*)(g), g1 = *(const f32x4n*)(g + 4);
            _Float16* xp = X + (size_t)R * 1024 + col;
            const h8 xv = *(const h8*)xp;
            const float y[8] = {__uint_as_float(yv.x << 16), __uint_as_float(yv.x & 0xffff0000u), __uint_as_float(yv.y << 16), __uint_as_float(yv.y & 0xffff0000u),
                                __uint_as_float(yv.z << 16), __uint_as_float(yv.z & 0xffff0000u), __uint_as_float(yv.w << 16), __uint_as_float(yv.w & 0xffff0000u)};
            const float gg[8] = {g0.x, g0.y, g0.z, g0.w, g1.x, g1.y, g1.z, g1.w};
            h8 o;
#pragma unroll
            for (int q = 0; q < 8; ++q) o[q] = (_Float16)(ALPHA * (float)xv[q] + gg[q] * y[q]);
            *(h8*)xp = o;
          }
        }
      }
    }
    __syncthreads();
  }
};

struct EpiQKV {
  int odd, row0, ntile;
  u16 *QO, *Kb, *VT;
  const f32x2n* rope;
  const float* qkn;
  u16* ostage;
  DI void operator()(f32x16 (&acc)[2][4], int wm, int wn, int r, int h) {
    const int cgi = ntile * 4 + wn;
    u16* slab = ostage + (wm * 4 + wn) * (64 * 72);
    int kind, dst, do_rope, do_norm;
    if (!odd) {
      const int seg = cgi >> 3, idx = cgi & 7;
      kind = seg % 3;
      do_rope = (seg == 3 || seg == 4);
      do_norm = 0;
      if (seg == 0) dst = idx * 64;
      else if (seg == 1) dst = idx;
      else if (seg == 2) dst = idx * 64;
      else if (seg == 3) dst = 512 + idx * 64;
      else if (seg == 4) dst = 8 + idx;
      else dst = 512 + idx * 64;
    } else {
      if (cgi < 16) { kind = 0; dst = cgi * 64; do_rope = 1; do_norm = 1; }
      else if (cgi < 20) { kind = 1; dst = cgi - 16; do_rope = 1; do_norm = 1; }
      else { kind = 2; dst = (cgi - 20) * 64; do_rope = 0; do_norm = 0; }
    }
    const int nkh = odd ? 4 : 16, nvr = odd ? 256 : 1024;
    const float* gn = qkn + (kind == 1 ? 64 : 0);
#pragma unroll
    for (int mb = 0; mb < 4; ++mb) {
      const int R = row0 + wm * 128 + mb * 32 + r;
      const bool lat = R < NLAT;
      const int b = lat ? (R >> 11) : ((R - NLAT) >> 8);
      const int tu = lat ? (R & 2047) : 2048 + ((R - NLAT) & 255);
      float v[2][16];
#pragma unroll
      for (int nb = 0; nb < 2; ++nb)
#pragma unroll
        for (int i = 0; i < 16; ++i) v[nb][i] = acc[nb][mb][i];
      if (do_norm) {
        float ss = 0.f;
#pragma unroll
        for (int nb = 0; nb < 2; ++nb)
#pragma unroll
          for (int i = 0; i < 16; ++i) ss += v[nb][i] * v[nb][i];
        ss += shx(ss, (h * 32 + r), 32);
        const float rs = rsqrtf(ss * (1.f / 64.f) + EPS);
#pragma unroll
        for (int nb = 0; nb < 2; ++nb)
#pragma unroll
          for (int ig = 0; ig < 4; ++ig) {
            const f32x4n gv = *(const f32x4n*)(gn + nb * 32 + ig * 8 + h * 4);
            v[nb][ig * 4 + 0] *= rs * gv.x; v[nb][ig * 4 + 1] *= rs * gv.y;
            v[nb][ig * 4 + 2] *= rs * gv.z; v[nb][ig * 4 + 3] *= rs * gv.w;
          }
      }
      if (do_rope && lat) {
#pragma unroll
        for (int nb = 0; nb < 2; ++nb) {
          const int pos = (nb == 0) ? (tu >> 6) : (tu & 63);
#pragma unroll
          for (int i = 0; i < 8; ++i) {
            const f32x2n cs = rope[pos * 16 + crow(i, h)];
            const float x1 = v[nb][i], x2 = v[nb][i + 8];
            v[nb][i] = x1 * cs.x - x2 * cs.y;
            v[nb][i + 8] = x2 * cs.x + x1 * cs.y;
          }
        }
      }
      const int tokl = (mb & 1) * 32 + r;
      if (kind == 2) {
#pragma unroll
        for (int nb = 0; nb < 2; ++nb)
#pragma unroll
          for (int i = 0; i < 16; ++i) slab[(nb * 32 + crow(i, h)) * 72 + tokl] = f2bf(v[nb][i]);
      } else {
#pragma unroll
        for (int nb = 0; nb < 2; ++nb)
#pragma unroll
          for (int ig = 0; ig < 4; ++ig) {
            u32x2 o;
            o.x = pack2(v[nb][ig * 4 + 0], v[nb][ig * 4 + 1]);
            o.y = pack2(v[nb][ig * 4 + 2], v[nb][ig * 4 + 3]);
            *(u32x2*)(slab + tokl * 72 + nb * 32 + ig * 8 + h * 4) = o;
          }
      }
      if (mb & 1) {
        asm volatile("s_waitcnt lgkmcnt(0)" ::: "memory");
        const int lane = h * 32 + r;
        const int R0 = row0 + wm * 128 + (mb >> 1) * 64;
        const bool lat0 = R0 < NLAT;
        const int b0 = lat0 ? (R0 >> 11) : ((R0 - NLAT) >> 8);
        const int tu0 = lat0 ? (R0 & 2047) : 2048 + ((R0 - NLAT) & 255);
#pragma unroll
        for (int j = 0; j < 8; ++j) {
          const int rowl = (lane >> 3) + 8 * j, ch = lane & 7;
          const u32x4 val = *(const u32x4*)(slab + rowl * 72 + ch * 8);
          u16* dp;
          if (kind == 2) dp = VT + ((size_t)b0 * nvr + dst + rowl) * T + tu0 + ch * 8;
          else if (kind == 0) dp = QO + (size_t)(R0 + rowl) * 1024 + dst + ch * 8;
          else dp = Kb + (((size_t)b0 * nkh + dst) * T + tu0 + rowl) * 64 + ch * 8;
          *(u32x4*)dp = val;
        }
      }
    }
    __syncthreads();
  }
};

DI float gelu_tanh(float g) {
  const float u = g * g;
  const float t = g * (-2.302208198f - 0.1029432397f * u);
  const float e = ex2(t);
  return g * __builtin_amdgcn_rcpf(1.f + e);
}

struct EpiUp {
  u16* act; const float* cw; const float* cb; int row0, Mrows, nt; float* edge; u16* ostage;
  DI void operator()(f32x16 (&acc)[2][4], int wm, int wn, int r, int h) {
    float* eb = edge + ((wm * 4 + wn) * 2) * 64;
    if (r == 0) {
#pragma unroll
      for (int nb = 0; nb < 2; ++nb)
#pragma unroll
        for (int i = 0; i < 16; ++i) eb[nb * 32 + crow(i, h)] = acc[nb][0][i];
    }
    if (r == 31) {
#pragma unroll
      for (int nb = 0; nb < 2; ++nb)
#pragma unroll
        for (int i = 0; i < 16; ++i) eb[64 + nb * 32 + crow(i, h)] = acc[nb][3][i];
    }
    __syncthreads();
    const float* ob = edge + (((wm ^ 1) * 4 + wn) * 2) * 64 + (wm == 0 ? 0 : 64);
    const int sp = (h << 5) | ((r - 1) & 31), sn = (h << 5) | ((r + 1) & 31);
    const int Rb = row0 + wm * 128 + r;
    u16* ost = ostage + (wm * 4 + wn) * (128 * 40);
    float pm[4], nm[4];
#pragma unroll
    for (int mb = 0; mb < 4; ++mb) {
      const int R = Rb + mb * 32;
      const bool lat = R < NLAT;
      const int tt = lat ? (R & 2047) : ((R - NLAT) & 255);
      pm[mb] = (tt == 0) ? 0.f : 1.f;
      nm[mb] = (tt == (lat ? 2047 : 255)) ? 0.f : 1.f;
    }
#pragma unroll
    for (int ig = 0; ig < 4; ++ig)
#pragma unroll
      for (int qp = 0; qp < 2; ++qp) {
        const int i0 = ig * 4 + qp * 2;
        float u[2][4][2];
#pragma unroll
        for (int nb = 0; nb < 2; ++nb) {
          int xp[4];
#pragma unroll
          for (int mb = 0; mb < 4; ++mb) xp[mb] = (int)pack2(acc[nb][mb][i0], acc[nb][mb][i0 + 1]);
          const float eo0 = ob[nb * 32 + crow(i0, h)], eo1 = ob[nb * 32 + crow(i0 + 1, h)];
          float w0[2], w1[2], w2[2], bz[2];
          {
            const int ff = nt * 128 + wn * 32 + crow(i0, h) + nb * DFF;
            const f32x2n a0 = *(const f32x2n*)(cw + ff), a1 = *(const f32x2n*)(cw + 2 * DFF + ff), a2 = *(const f32x2n*)(cw + 4 * DFF + ff),
                         a3 = *(const f32x2n*)(cb + ff);
            w0[0] = a0.x; w0[1] = a0.y; w1[0] = a1.x; w1[1] = a1.y; w2[0] = a2.x; w2[1] = a2.y; bz[0] = a3.x; bz[1] = a3.y;
          }
          int spm = 0;
#pragma unroll
          for (int mb = 0; mb < 4; ++mb) {
            const int spc = __builtin_amdgcn_ds_bpermute(sp << 2, xp[mb]);
            const int snc = __builtin_amdgcn_ds_bpermute(sn << 2, xp[mb]);
            const int snn = (mb < 3) ? __builtin_amdgcn_ds_bpermute(sn << 2, xp[mb < 3 ? mb + 1 : 3]) : 0;
            const int pv = (mb > 0) ? ((r == 0) ? spm : spc) : spc;
            const int nv = (mb < 3) ? ((r == 31) ? snn : snc) : snc;
            float prev0 = __int_as_float(pv << 16), prev1 = __int_as_float(pv & 0xffff0000);
            float next0 = __int_as_float(nv << 16), next1 = __int_as_float(nv & 0xffff0000);
            if (mb == 0 && r == 0) { prev0 = eo0; prev1 = eo1; }
            if (mb == 3 && r == 31) { next0 = eo0; next1 = eo1; }
            spm = spc;
            prev0 *= pm[mb]; prev1 *= pm[mb];
            next0 *= nm[mb]; next1 *= nm[mb];
            u[nb][mb][0] = w0[0] * prev0 + w1[0] * acc[nb][mb][i0] + w2[0] * next0 + bz[0];
            u[nb][mb][1] = w0[1] * prev1 + w1[1] * acc[nb][mb][i0 + 1] + w2[1] * next1 + bz[1];
          }
        }
#pragma unroll
        for (int mb = 0; mb < 4; ++mb)
          *(unsigned*)(ost + (mb * 32 + r) * 40 + ig * 8 + h * 4 + qp * 2) =
              pack2(gelu_tanh(u[1][mb][0]) * u[0][mb][0], gelu_tanh(u[1][mb][1]) * u[0][mb][1]);
      }
    asm volatile("s_waitcnt lgkmcnt(0)" ::: "memory");
    const int lane = h * 32 + r;
#pragma unroll
    for (int j = 0; j < 8; ++j) {
      const int tk = (lane >> 2) + 16 * j, ch = lane & 3;
      const int tr = wm * 128 + tk;
      const int R = row0 + tr;
      const u32x4 v = *(const u32x4*)(ost + tk * 40 + ch * 8);
      if ((tr >= 1) && (tr <= 254) && (R >= 0) && (R < Mrows))
        *(u32x4*)(act + (size_t)R * DFF + nt * 128 + wn * 32 + ch * 8) = v;
    }
    __syncthreads();
  }
};

DI bool tile_map(int id, int NT, int MT, int& mt, int& nt) {
  const int x = id & 7, q = id >> 3;
  nt = q % NT;
  mt = (q / NT) * 8 + x;
  return mt < MT;
}

DI void phase_qkv(const Params& p, int l, char* smem) {
  const int odd = l & 1;
  const int NT = odd ? 6 : 12;
  const u16* W = odd ? (const u16*)(p.ws + OFF_WIN_O) + (size_t)(l >> 1) * 1536 * 1024 : (const u16*)(p.ws + OFF_WIN_E) + (size_t)(l >> 1) * 3072 * 1024;
  const u16* H = (const u16*)(p.ws + OFF_H);
  for (int tile = bid(); tile < 144 * NT; tile += gridDim.x) {
    int mt, nt;
    if (!tile_map(tile, NT, 144, mt, nt)) continue;
    EpiQKV e;
    e.odd = odd; e.row0 = mt * 256; e.ntile = nt;
    e.QO = (u16*)(p.ws + OFF_QO); e.Kb = (u16*)(p.ws + OFF_K); e.VT = (u16*)(p.ws + OFF_VT);
    e.rope = (const f32x2n*)(p.ws + OFF_ROPE);
    e.qkn = p.gqa_qk_norm + (l >> 1) * 128;
    e.ostage = (u16*)smem;
    gemm_tile<4>(H, 1024, mt * 256, NROWS, W + (size_t)nt * 256 * 1024, 1024, 1024, smem, e, tile);
  }
}

struct EpiNull {
  float* sink;
  DI void operator()(f32x16 (&acc)[2][4], int wm, int wn, int r, int h) {
    float s = 0.f;
#pragma unroll
    for (int nb = 0; nb < 2; ++nb)
#pragma unroll
      for (int mb = 0; mb < 4; ++mb)
#pragma unroll
        for (int i = 0; i < 16; ++i) s += acc[nb][mb][i];
    if (s == 123.456f) *sink = s;
  }
};
DI void phase_qkv_null(const Params& p, int l, char* smem) {
  const int odd = l & 1;
  const int NT = odd ? 6 : 12;
  const u16* W = odd ? (const u16*)(p.ws + OFF_WIN_O) + (size_t)(l >> 1) * 1536 * 1024 : (const u16*)(p.ws + OFF_WIN_E) + (size_t)(l >> 1) * 3072 * 1024;
  const u16* H = (const u16*)(p.ws + OFF_H);
  for (int tile = bid(); tile < 144 * NT; tile += gridDim.x) {
    int mt, nt;
    if (!tile_map(tile, NT, 144, mt, nt)) continue;
    EpiNull e;
    e.sink = (float*)(p.ws + OFF_LAM + 64);
    gemm_tile<4>(H, 1024, mt * 256, NROWS, W + (size_t)nt * 256 * 1024, 1024, 1024, smem, e, tile);
  }
}

template <int MB>
DI void phase_res_t(const Params& p, int l, int which, char* smem) {
  constexpr int TR = 64 * MB;
  const int rows = (l == 3) ? NLAT : NROWS;
  const int MT = rows / TR;
  const u16* A = which ? (const u16*)(p.ws + OFF_ACT) : (const u16*)(p.ws + OFF_QO);
  const int lda = which ? DFF : 1024, K = which ? DFF : 1024;
  const u16* W = which ? (const u16*)(p.ws + OFF_WD) + (size_t)l * 1024 * DFF : (const u16*)(p.ws + OFF_WO) + (size_t)l * 1024 * 1024;
  const float* gate = (const float*)(p.ws + OFF_MODS) + (size_t)l * 17 * 6144 + (which ? 5 : 2) * 1024;
  for (int tile = bid(); tile < MT * 4; tile += gridDim.x) {
    int mt, nt;
    if (!tile_map(tile, 4, MT, mt, nt)) continue;
    EpiRes<MB> e;
    e.X = (_Float16*)(p.ws + OFF_X); e.gate = gate; e.row0 = mt * TR; e.n0 = nt * 256; e.ostage = (u16*)smem;
    gemm_tile<MB>(A, lda, mt * TR, rows, W + (size_t)nt * 256 * K, K, K, smem, e, tile);
  }
}
DI void phase_res(const Params& p, int l, int which, char* smem) {
  if (l == 3) phase_res_t<4>(p, l, which, smem);
  else phase_res_t<3>(p, l, which, smem);
}

DI void phase_up(const Params& p, int l, char* smem) {
  const int rows = (l == 3) ? NLAT : NROWS;
  const int MT = (rows + 253) / 254;
  const int MTP = (MT + 7) & ~7;
  const u16* W = (const u16*)(p.ws + OFF_WUP) + (size_t)l * 5632 * 1024;
  const u16* H = (const u16*)(p.ws + OFF_H);
  for (int tile = bid(); tile < MTP * 22; tile += gridDim.x) {
    int mt, nt;
    if (!tile_map(tile, 22, MT, mt, nt)) continue;
    EpiUp e;
    e.act = (u16*)(p.ws + OFF_ACT); e.cw = p.conv_w + (size_t)l * 3 * 5632; e.cb = p.conv_b + (size_t)l * 5632;
    e.row0 = mt * 254 - 1; e.Mrows = rows; e.nt = nt; e.edge = (float*)(smem + 131072); e.ostage = (u16*)smem;
    gemm_tile<4>(H, 1024, mt * 254 - 1, rows, W + (size_t)nt * 256 * 1024, 1024, 1024, smem, e, tile);
  }
}

struct AttnArgs {
  u16* qo;
  const u16 *k1, *k2, *vt;
  int s0, n0, n1;
  const float* rpb;
  int rq0, us;
  float lam, oml;
  const float* subln;
};

template <int DV, int MODE>
DI void attn_item(const AttnArgs& a, char* smem) {
  u16* Ks1 = (u16*)smem;
  u16* Ks2 = (u16*)(smem + 9216);
  u16* Vs = (u16*)(smem + 18432);
  float* rpbS = (float*)(smem + 36864);
  const int t = tid(), lane = t & 63, w = __builtin_amdgcn_readfirstlane(t >> 6), r = lane & 31, h = lane >> 5;
  constexpr int NDV = DV / 32;
  constexpr int NVL = DV / 64;
  const int nt = a.n0 + a.n1;

  const int qrow = (MODE == 1) ? ((w & 3) * 32 + r) : (w * 32 + r);
  const int qcoff = (MODE == 1) ? ((w >> 2) * 64) : 0;
  u16* qp = a.qo + (size_t)qrow * 1024;
  bf8 qf[4];
#pragma unroll
  for (int ks = 0; ks < 4; ++ks) qf[ks] = *(const bf8*)(qp + qcoff + ks * 16 + h * 8);
  const u16* Ks = (MODE == 1 && (w >> 2)) ? Ks2 : Ks1;

  int rq = 0, qc = 0, cs = 0, rsw = 0;
  if (MODE == 2) {
    __syncthreads();
    for (int e = t; e < 15 * 32; e += NTHR) {
      const int dr = e >> 5, dc = e & 31;
      rpbS[e] = (dc < 31) ? a.rpb[dr * 31 + dc] * LOG2E : 0.f;
    }
    rq = a.rq0 + (w >> 1);
    qc = (w & 1) * 32 + r;
    cs = qc - 8; cs = cs < 0 ? 0 : (cs > 48 ? 48 : cs);
    rsw = rq - 4; rsw = rsw < 0 ? 0 : (rsw > 24 ? 24 : rsw);
  }

  f32x16 O[NDV];
#pragma unroll
  for (int d = 0; d < NDV; ++d)
#pragma unroll
    for (int i = 0; i < 16; ++i) O[d][i] = 0.f;
  float m = -1e30f, lsum = 0.f;

  u32x4 rk1, rk2, rv[NVL];
  const int srow = t >> 3, sch = t & 7;
#define ATTN_FETCH(TT)                                                                                         \
  {                                                                                                            \
    const int tt_ = (TT);                                                                                      \
    const int key0_ = tt_ < a.n0 ? a.s0 + tt_ * 64 : 2048 + (tt_ - a.n0) * 64;                                 \
    rk1 = *(const u32x4*)(a.k1 + (size_t)(key0_ + srow) * 64 + sch * 8);                                       \
    if (MODE == 1) rk2 = *(const u32x4*)(a.k2 + (size_t)(key0_ + srow) * 64 + sch * 8);                        \
    _Pragma("unroll") for (int j = 0; j < NVL; ++j)                                                            \
        rv[j] = *(const u32x4*)(a.vt + (size_t)(srow + 64 * j) * T + key0_ + sch * 8);                         \
  }
  if (nt > 0) ATTN_FETCH(0)
  for (int tt = 0; tt < nt; ++tt) {
    __syncthreads();
    *(u32x4*)(Ks1 + srow * 72 + sch * 8) = rk1;
    if (MODE == 1) *(u32x4*)(Ks2 + srow * 72 + sch * 8) = rk2;
#pragma unroll
    for (int j = 0; j < NVL; ++j) *(u32x4*)(Vs + (srow + 64 * j) * 72 + sch * 8) = rv[j];
    __syncthreads();
    if (tt + 1 < nt) ATTN_FETCH(tt + 1)
    __builtin_amdgcn_sched_barrier(0);

    bool active = true;
    int kr = 0;
    const bool local = (MODE == 2) && (tt < a.n0);
    if (local) { kr = a.us + tt; active = (kr >= rsw) && (kr < rsw + 8); }
    if (active) {
      f32x16 s[2];
#pragma unroll
      for (int kb = 0; kb < 2; ++kb) {
#pragma unroll
        for (int i = 0; i < 16; ++i) s[kb][i] = 0.f;
#pragma unroll
        for (int ks = 0; ks < 4; ++ks) {
          const bf8 kf = *(const bf8*)(Ks + (kb * 32 + r) * 72 + ks * 16 + h * 8);
          s[kb] = mfma32(kf, qf[ks], s[kb]);
        }
      }
      constexpr float SC = 0.125f * LOG2E;
      float mx = -INFINITY;
      if (local) {
#pragma unroll
        for (int kb = 0; kb < 2; ++kb)
#pragma unroll
          for (int i = 0; i < 16; ++i) {
            const int kc = kb * 32 + crow(i, h);
            const bool ok = (kc >= cs) && (kc < cs + 16);
            const int dc = kc - qc + 15;
            const int dr = kr - rq + 7;
            const float bias = rpbS[dr * 32 + (ok ? dc : 0)];
            const float v = ok ? (s[kb][i] + bias * (1.f / SC)) : -INFINITY;
            s[kb][i] = v;
            mx = fmaxf(mx, v);
          }
      } else {
#pragma unroll
        for (int kb = 0; kb < 2; ++kb)
#pragma unroll
          for (int i = 0; i < 16; i += 2) mx = fmaxf(fmaxf(mx, s[kb][i]), s[kb][i + 1]);
      }
      mx = fmaxf(mx, shx(mx, lane, 32)) * SC;
      const float mn = fmaxf(m, mx);
      const bool resc = __builtin_amdgcn_ballot_w64(mn != m) != 0ull;
      float ps0 = 0.f, ps1 = 0.f;
#pragma unroll
      for (int kb = 0; kb < 2; ++kb)
#pragma unroll
        for (int i = 0; i < 16; i += 2) {
          f32x2n v = {s[kb][i], s[kb][i + 1]};
          v = v * f32x2n{SC, SC} - f32x2n{mn, mn};
          const float p0 = ex2(v.x), p1 = ex2(v.y);
          s[kb][i] = p0; s[kb][i + 1] = p1;
          ps0 += p0; ps1 += p1;
        }
      if (resc) {
        const float alpha = ex2(m - mn);
        m = mn;
        lsum *= alpha;
#pragma unroll
        for (int d = 0; d < NDV; ++d)
#pragma unroll
          for (int i = 0; i < 16; ++i) O[d][i] *= alpha;
      }
      lsum += ps0 + ps1;
#pragma unroll
      for (int kb = 0; kb < 2; ++kb)
#pragma unroll
        for (int s2 = 0; s2 < 2; ++s2) {
          u32x4 pk;
          pk.x = pack2(s[kb][s2 * 8 + 0], s[kb][s2 * 8 + 1]);
          pk.y = pack2(s[kb][s2 * 8 + 2], s[kb][s2 * 8 + 3]);
          pk.z = pack2(s[kb][s2 * 8 + 4], s[kb][s2 * 8 + 5]);
          pk.w = pack2(s[kb][s2 * 8 + 6], s[kb][s2 * 8 + 7]);
          const bf8 pf = __builtin_bit_cast(bf8, pk);
#pragma unroll
          for (int d = 0; d < NDV; ++d) {
            const u16* vp = Vs + (d * 32 + r) * 72 + kb * 32 + s2 * 16 + 4 * h;
            u32x4 vv;
            const u32x2 lo = *(const u32x2*)(vp);
            const u32x2 hi = *(const u32x2*)(vp + 8);
            vv.x = lo.x; vv.y = lo.y; vv.z = hi.x; vv.w = hi.y;
            O[d] = mfma32(__builtin_bit_cast(bf8, vv), pf, O[d]);
          }
        }
    }
  }
  const float ltot = lsum + shx(lsum, lane, 32);
  const float inv = 1.f / ltot;
  if (MODE != 1) {
#pragma unroll
    for (int d = 0; d < NDV; ++d)
#pragma unroll
      for (int ig = 0; ig < 4; ++ig) {
        u32x2 o;
        o.x = pack2(O[d][ig * 4 + 0] * inv, O[d][ig * 4 + 1] * inv);
        o.y = pack2(O[d][ig * 4 + 2] * inv, O[d][ig * 4 + 3] * inv);
        *(u32x2*)(qp + d * 32 + ig * 8 + h * 4) = o;
      }
  } else {
    float* comb = (float*)smem;
    __syncthreads();
    if (w >= 4) {
#pragma unroll
      for (int d = 0; d < NDV; ++d)
#pragma unroll
        for (int i = 0; i < 16; ++i) comb[((w - 4) * 128 + d * 32 + crow(i, h)) * 32 + r] = O[d][i] * inv;
    }
    __syncthreads();
    if (w < 4) {
      float ss = 0.f;
#pragma unroll
      for (int d = 0; d < NDV; ++d)
#pragma unroll
        for (int i = 0; i < 16; ++i) {
          const float o = O[d][i] * inv - a.lam * comb[(w * 128 + d * 32 + crow(i, h)) * 32 + r];
          O[d][i] = o;
          ss += o * o;
        }
      ss += shx(ss, lane, 32);
      const float rs = rsqrtf(ss * (1.f / 128.f) + EPS) * a.oml;
#pragma unroll
      for (int d = 0; d < NDV; ++d)
#pragma unroll
        for (int ig = 0; ig < 4; ++ig) {
          const f32x4n gv = *(const f32x4n*)(a.subln + d * 32 + ig * 8 + h * 4);
          u32x2 o;
          o.x = pack2(O[d][ig * 4 + 0] * rs * gv.x, O[d][ig * 4 + 1] * rs * gv.y);
          o.y = pack2(O[d][ig * 4 + 2] * rs * gv.z, O[d][ig * 4 + 3] * rs * gv.w);
          *(u32x2*)(qp + d * 32 + ig * 8 + h * 4) = o;
        }
    }
  }
}

DI void attn_item_q64(const AttnArgs& a, char* smem) {
  char* Kb_ = smem;
  char* Vb_ = smem + 16384;
  const unsigned lds_base = (unsigned)(size_t)(lds_char*)smem;
  const int t = tid(), lane = t & 63, w = __builtin_amdgcn_readfirstlane(t >> 6), r = lane & 31, h = lane >> 5;
  const int nt = a.n0 + a.n1;
  u16* qp[2];
  bf8 qf[2][4];
#pragma unroll
  for (int q2 = 0; q2 < 2; ++q2) {
    qp[q2] = a.qo + (size_t)(w * 64 + q2 * 32 + r) * 1024;
#pragma unroll
    for (int ks = 0; ks < 4; ++ks) qf[q2][ks] = *(const bf8*)(qp[q2] + ks * 16 + h * 8);
  }
  f32x16 O[2][2];
#pragma unroll
  for (int q2 = 0; q2 < 2; ++q2)
#pragma unroll
    for (int d = 0; d < 2; ++d)
#pragma unroll
      for (int i = 0; i < 16; ++i) O[q2][d][i] = 0.f;
  float m[2] = {-1e30f, -1e30f}, lsum[2] = {0.f, 0.f};
  const int srow = t >> 3, sch = (t & 7) ^ ((srow >> 1) & 7);
  const u16* kg = a.k1 + (size_t)srow * 64 + sch * 8;
  const u16* vg = a.vt + (size_t)srow * T + sch * 8;
#define ATTN2_ISSUE(TT, BUF)                                                                                   \
  {                                                                                                            \
    const int tt_ = (TT) < nt ? (TT) : nt - 1;                                                                 \
    const int key0_ = tt_ < a.n0 ? a.s0 + tt_ * 64 : 2048 + (tt_ - a.n0) * 64;                                 \
    glds16(kg + (size_t)key0_ * 64, lds_base + (BUF) * 8192 + w * 1024);                                       \
    glds16(vg + key0_, lds_base + 16384 + (BUF) * 8192 + w * 1024);                                            \
  }
  __syncthreads();
  ATTN2_ISSUE(0, 0)
  ATTN2_ISSUE(1, 1)
  asm volatile("s_waitcnt vmcnt(2)" ::: "memory");
  __syncthreads();
  const int sw = (r >> 1) & 7;
  int koff[4];
#pragma unroll
  for (int ks = 0; ks < 4; ++ks) koff[ks] = r * 128 + (((2 * ks + h) ^ sw) << 4);
  for (int tt = 0; tt < nt; ++tt) {
    const char* Ks = Kb_ + (tt & 1) * 8192;
    const char* Vs = Vb_ + (tt & 1) * 8192;
    f32x16 s[2][2];
#pragma unroll
    for (int kb = 0; kb < 2; ++kb) {
#pragma unroll
      for (int q2 = 0; q2 < 2; ++q2)
#pragma unroll
        for (int i = 0; i < 16; ++i) s[q2][kb][i] = 0.f;
#pragma unroll
      for (int ks = 0; ks < 4; ++ks) {
        const bf8 kf = *(const bf8*)(Ks + kb * 32 * 128 + koff[ks]);
#pragma unroll
        for (int q2 = 0; q2 < 2; ++q2) s[q2][kb] = mfma32(kf, qf[q2][ks], s[q2][kb]);
      }
    }
    constexpr float SC = 0.125f * LOG2E;
#pragma unroll
    for (int q2 = 0; q2 < 2; ++q2) {
      float mx = -INFINITY;
#pragma unroll
      for (int kb = 0; kb < 2; ++kb)
#pragma unroll
        for (int i = 0; i < 16; i += 2) mx = fmaxf(fmaxf(mx, s[q2][kb][i]), s[q2][kb][i + 1]);
      mx = fmaxf(mx, shx(mx, lane, 32)) * SC;
      const float mn = fmaxf(m[q2], mx);
      const bool resc = __builtin_amdgcn_ballot_w64(mn != m[q2]) != 0ull;
      float ps0 = 0.f, ps1 = 0.f;
#pragma unroll
      for (int kb = 0; kb < 2; ++kb)
#pragma unroll
        for (int i = 0; i < 16; i += 2) {
          f32x2n v = {s[q2][kb][i], s[q2][kb][i + 1]};
          v = v * f32x2n{SC, SC} - f32x2n{mn, mn};
          const float p0 = ex2(v.x), p1 = ex2(v.y);
          s[q2][kb][i] = p0; s[q2][kb][i + 1] = p1;
          ps0 += p0; ps1 += p1;
        }
      if (resc) {
        const float alpha = ex2(m[q2] - mn);
        m[q2] = mn;
        lsum[q2] *= alpha;
#pragma unroll
        for (int d = 0; d < 2; ++d)
#pragma unroll
          for (int i = 0; i < 16; ++i) O[q2][d][i] *= alpha;
      }
      lsum[q2] += ps0 + ps1;
    }
#pragma unroll
    for (int kb = 0; kb < 2; ++kb)
#pragma unroll
      for (int s2 = 0; s2 < 2; ++s2) {
        const int kk = kb * 2 + s2;
        bf8 pf[2];
#pragma unroll
        for (int q2 = 0; q2 < 2; ++q2) {
          u32x4 pk;
          pk.x = pack2(s[q2][kb][s2 * 8 + 0], s[q2][kb][s2 * 8 + 1]);
          pk.y = pack2(s[q2][kb][s2 * 8 + 2], s[q2][kb][s2 * 8 + 3]);
          pk.z = pack2(s[q2][kb][s2 * 8 + 4], s[q2][kb][s2 * 8 + 5]);
          pk.w = pack2(s[q2][kb][s2 * 8 + 6], s[q2][kb][s2 * 8 + 7]);
          pf[q2] = __builtin_bit_cast(bf8, pk);
        }
#pragma unroll
        for (int d = 0; d < 2; ++d) {
          const char* vrow = Vs + (d * 32 + r) * 128 + 8 * h;
          u32x4 vv;
          const u32x2 lo = *(const u32x2*)(vrow + (((2 * kk) ^ sw) << 4));
          const u32x2 hi = *(const u32x2*)(vrow + (((2 * kk + 1) ^ sw) << 4));
          vv.x = lo.x; vv.y = lo.y; vv.z = hi.x; vv.w = hi.y;
          const bf8 vf = __builtin_bit_cast(bf8, vv);
#pragma unroll
          for (int q2 = 0; q2 < 2; ++q2) O[q2][d] = mfma32(vf, pf[q2], O[q2][d]);
        }
      }
    asm volatile("s_waitcnt vmcnt(0)" ::: "memory");
    __syncthreads();
    if (tt + 2 < nt) ATTN2_ISSUE(tt + 2, tt & 1)
  }
#pragma unroll
  for (int q2 = 0; q2 < 2; ++q2) {
    const float ltot = lsum[q2] + shx(lsum[q2], lane, 32);
    const float inv = 1.f / ltot;
#pragma unroll
    for (int d = 0; d < 2; ++d)
#pragma unroll
      for (int ig = 0; ig < 4; ++ig) {
        u32x2 o;
        o.x = pack2(O[q2][d][ig * 4 + 0] * inv, O[q2][d][ig * 4 + 1] * inv);
        o.y = pack2(O[q2][d][ig * 4 + 2] * inv, O[q2][d][ig * 4 + 3] * inv);
        *(u32x2*)(qp[q2] + d * 32 + ig * 8 + h * 4) = o;
      }
  }
}

DI void phase_attn(const Params& p, int l, char* smem) {
  u16* QO = (u16*)(p.ws + OFF_QO);
  const u16* Kb = (const u16*)(p.ws + OFF_K);
  const u16* VT = (const u16*)(p.ws + OFF_VT);
  const bool need_ctx = l < 3;
  if (l & 1) {
    const int total = 1024 + (need_ctx ? 256 : 0);
    for (int id = bid(); id < total; id += gridDim.x) {
      AttnArgs a;
      a.k2 = nullptr; a.rpb = nullptr; a.rq0 = 0; a.us = 0; a.lam = 0.f; a.oml = 0.f; a.subln = nullptr;
      if (id < 1024) {
        const int x = id & 7, q = id >> 3, within = q & 15, g = (q >> 4) * 8 + x;
        const int b = g >> 2, kvh = g & 3, hq = kvh * 4 + (within >> 2), qb = within & 3;
        a.qo = QO + (size_t)(b * 2048 + qb * 512) * 1024 + hq * 64;
        a.k1 = Kb + ((size_t)b * 4 + kvh) * T * 64;
        a.vt = VT + ((size_t)b * 256 + kvh * 64) * T;
        a.s0 = 0; a.n0 = 32; a.n1 = 4;
        attn_item_q64(a, smem);
        continue;
      } else {
        const int id2 = id - 1024;
        const int hq = id2 & 15, b = id2 >> 4, kvh = hq >> 2;
        a.qo = QO + (size_t)(NLAT + b * 256) * 1024 + hq * 64;
        a.k1 = Kb + ((size_t)b * 4 + kvh) * T * 64;
        a.vt = VT + ((size_t)b * 256 + kvh * 64) * T;
        a.s0 = 0; a.n0 = 0; a.n1 = 4;
      }
      attn_item<64, 0>(a, smem);
    }
  } else {
    const int li = l >> 1;
    const float lam = ((const float*)(p.ws + OFF_LAM))[li];
    const float oml = 1.f - ((li == 0) ? 0.2f : 0.47071301834358393f);
    const int total = 1024 + 1024 + (need_ctx ? 128 + 128 : 0);
    for (int id = bid(); id < total; id += gridDim.x) {
      AttnArgs a;
      a.k2 = nullptr; a.rpb = nullptr; a.rq0 = 0; a.us = 0; a.lam = lam; a.oml = oml; a.subln = p.diff_subln + li * 128;
      if (id < 1024) {
        const int x = id & 7, q = id >> 3, qb = q & 15, g = (q >> 4) * 8 + x;
        const int b = g >> 2, j = g & 3;
        a.qo = QO + (size_t)(b * 2048 + qb * 128) * 1024 + 512 + j * 128;
        a.k1 = Kb + ((size_t)b * 16 + 8 + 2 * j) * T * 64;
        a.k2 = Kb + ((size_t)b * 16 + 8 + 2 * j + 1) * T * 64;
        a.vt = VT + ((size_t)b * 1024 + 512 + j * 128) * T;
        a.s0 = 0; a.n0 = 32; a.n1 = 4;
        attn_item<128, 1>(a, smem);
      } else if (id < 2048) {
        const int id2 = id - 1024;
        const int x = id2 & 7, q = id2 >> 3, pr = q & 7, g = (q >> 3) * 8 + x;
        const int b = g >> 3, hd = g & 7;
        const int r0 = 4 * pr;
        int rs0 = r0 - 4; rs0 = rs0 < 0 ? 0 : (rs0 > 24 ? 24 : rs0);
        int rs3 = r0 - 1; rs3 = rs3 < 0 ? 0 : (rs3 > 24 ? 24 : rs3);
        a.qo = QO + (size_t)(b * 2048 + r0 * 64) * 1024 + hd * 64;
        a.k1 = Kb + ((size_t)b * 16 + hd) * T * 64;
        a.vt = VT + ((size_t)b * 1024 + hd * 64) * T;
        a.s0 = rs0 * 64; a.n0 = rs3 + 8 - rs0; a.n1 = 4;
        a.rpb = p.na_rpb + ((size_t)li * 8 + hd) * 15 * 31;
        a.rq0 = r0; a.us = rs0;
        attn_item<64, 2>(a, smem);
      } else if (id < 2048 + 128) {
        const int g = id - 2048, b = g >> 3, hd = g & 7;
        a.qo = QO + (size_t)(NLAT + b * 256) * 1024 + hd * 64;
        a.k1 = Kb + ((size_t)b * 16 + hd) * T * 64;
        a.vt = VT + ((size_t)b * 1024 + hd * 64) * T;
        a.s0 = 0; a.n0 = 0; a.n1 = 4;
        attn_item<64, 0>(a, smem);
      } else {
        const int id2 = id - 2048 - 128;
        const int qb = id2 & 1, g = id2 >> 1, b = g >> 2, j = g & 3;
        a.qo = QO + (size_t)(NLAT + b * 256 + qb * 128) * 1024 + 512 + j * 128;
        a.k1 = Kb + ((size_t)b * 16 + 8 + 2 * j) * T * 64;
        a.k2 = Kb + ((size_t)b * 16 + 8 + 2 * j + 1) * T * 64;
        a.vt = VT + ((size_t)b * 1024 + 512 + j * 128) * T;
        a.s0 = 0; a.n0 = 0; a.n1 = 4;
        attn_item<128, 1>(a, smem);
      }
    }
  }
}

constexpr int N_PHASES = 30;
DI void run_phase(const Params& p, int ph, char* smem) {
  if (ph == 0) {
    phase0_mods(p, smem);
    phase0_weights(p, smem, 0);
    phase0_misc(p);
    return;
  }
  if (ph == 29) { phase_final(p); return; }
  const int l = (ph - 1) / 7, s = (ph - 1) % 7;
  switch (s) {
    case 0: phase_prep(p, l, 0); break;
    case 1: phase_qkv(p, l, smem); break;
    case 2: phase_attn(p, l, smem); break;
    case 3: phase_res(p, l, 0, smem); break;
    case 4: phase_prep(p, l, 1); break;
    case 5: phase_up(p, l, smem); break;
    default: phase_res(p, l, 1, smem); break;
  }
}

#if MK_MULTI
__global__ void __launch_bounds__(512, 2) fwd_megakernel(Params p, int ph_lo, int ph_hi) {
  __shared__ __attribute__((aligned(16))) char smem[SMEM_BYTES];
  for (int ph = ph_lo; ph < ph_hi; ++ph) run_phase(p, ph, smem);
}
#else
#if USE_XCD_BARRIER
#define GRID_BARRIER() xcd_barrier(xb)
#else
#define GRID_BARRIER() grid.sync()
#endif
__global__ void __launch_bounds__(512, 2) fwd_megakernel(Params p, int ph_lo, int ph_hi) {
  __shared__ __attribute__((aligned(16))) char smem[SMEM_BYTES];
  __shared__ __attribute__((aligned(16))) unsigned xb_words[4];
  cg::grid_group grid = cg::this_grid();
  if (threadIdx.x < 4) xb_words[threadIdx.x] = 0u;
  __syncthreads();
  const XcdBarrier xb = xcd_barrier_post((unsigned*)(p.ws + OFF_BAR), (volatile LAS unsigned*)xb_words);
  phase0_mods(p, smem);
  phase0_weights(p, smem, 0);
  phase0_misc(p);
  if (p.out == nullptr) grid.sync();
  GRID_BARRIER();
#pragma unroll 1
  for (int l = 0; l < 4; ++l) {
    phase_prep(p, l, 0);
    GRID_BARRIER();
#if PROBE == 1
    phase_qkv(p, l, smem);
    GRID_BARRIER();
    phase_attn(p, l, smem);
    GRID_BARRIER();
#endif
#if PROBE == 2
    phase_qkv(p, l, smem);
    GRID_BARRIER();
#endif
#if PROBE == 4
    phase_qkv_null(p, l, smem);
    GRID_BARRIER();
#endif
#if PROBE == 5
    GRID_BARRIER(); GRID_BARRIER(); GRID_BARRIER(); GRID_BARRIER(); GRID_BARRIER(); GRID_BARRIER(); GRID_BARRIER();
#endif
    phase_qkv(p, l, smem);
    GRID_BARRIER();
    if (l == 0 && (bid() & 1)) phase0_weights(p, smem, 1);
    phase_attn(p, l, smem);
    if (l == 0 && !(bid() & 1)) phase0_weights(p, smem, 1);
    GRID_BARRIER();
    phase_res(p, l, 0, smem);
    GRID_BARRIER();
    phase_prep(p, l, 1);
    GRID_BARRIER();
#if PROBE == 3
    phase_up(p, l, smem);
    GRID_BARRIER();
#endif
    phase_up(p, l, smem);
    GRID_BARRIER();
    phase_res(p, l, 1, smem);
    GRID_BARRIER();
  }
  phase_final(p);
}
#endif

extern "C" void kernel_launch(void* const* d_in, const int* in_sizes, int n_in, void* d_out, int out_size, void* d_ws, size_t ws_size,
                              hipStream_t stream) {
  static int grid_blocks = 0;
  if (!grid_blocks) {
    int dev = 0, cus = 0, per_cu = 0;
    hipGetDevice(&dev);
    hipDeviceGetAttribute(&cus, hipDeviceAttributeMultiprocessorCount, dev);
    hipOccupancyMaxActiveBlocksPerMultiprocessor(&per_cu, fwd_megakernel, NTHR, 0);
    per_cu = 1;
    grid_blocks = cus * per_cu;
  }
  if (ws_size < WS_NEEDED) fprintf(stderr, "workspace too small: %zu < %zu\n", ws_size, (size_t)WS_NEEDED);
  Params p{};
  p.x = (const float*)d_in[0]; p.c = (const float*)d_in[1]; p.ctx = (const float*)d_in[2]; p.c_ctx = (const float*)d_in[3];
  p.w_ada = (const float*)d_in[4]; p.b_ada = (const float*)d_in[5]; p.ln_g = (const float*)d_in[6]; p.ln_b = (const float*)d_in[7];
  p.w_in_ab = (const float*)d_in[8]; p.w_o_ab = (const float*)d_in[9]; p.na_rpb = (const float*)d_in[10];
  p.diff_lambda = (const float*)d_in[11]; p.diff_subln = (const float*)d_in[12]; p.w_in_c = (const float*)d_in[13];
  p.w_o_c = (const float*)d_in[14]; p.gqa_qk_norm = (const float*)d_in[15]; p.w_up = (const float*)d_in[16];
  p.conv_w = (const float*)d_in[17]; p.conv_b = (const float*)d_in[18]; p.w_down = (const float*)d_in[19];
  p.out = (float*)d_out;
  p.ws = (char*)d_ws;
  hipMemsetAsync((char*)d_ws + OFF_BAR, 0, 16384, stream);
#if MK_MULTI
  for (int ph = 0; ph < N_PHASES; ++ph) {
    hipLaunchKernelGGL(fwd_megakernel, dim3(grid_blocks), dim3(NTHR), 0, stream, p, ph, ph + 1);
  }
#else
  int lo = 0, hi = N_PHASES;
  void* args[] = {&p, &lo, &hi};
  hipError_t e = hipLaunchCooperativeKernel((void*)fwd_megakernel, dim3(grid_blocks), dim3(NTHR), args, 0, stream);
  if (e != hipSuccess) fprintf(stderr, "cooperative launch failed: %s (grid %d)\n", hipGetErrorString(e), grid_blocks);
#endif
}
```

```cpp
#include <hip/hip_runtime.h>
#include <hip/hip_cooperative_groups.h>
#include <cstdio>
namespace cg = cooperative_groups;

#ifndef PROBE
#define PROBE 0
#endif
#ifndef USE_XCD_BARRIER
#define USE_XCD_BARRIER 1
#endif
#ifndef MK_MULTI
#define MK_MULTI 0
#endif

#define DI __device__ __forceinline__
typedef unsigned short u16;
typedef __attribute__((ext_vector_type(8))) __bf16 bf8;
typedef __attribute__((ext_vector_type(2))) __bf16 bf2;
typedef __attribute__((ext_vector_type(2))) float f2;
typedef __attribute__((ext_vector_type(16))) float f32x16;
typedef __attribute__((ext_vector_type(4))) _Float16 h4;
typedef __attribute__((ext_vector_type(8))) _Float16 h8;
typedef __attribute__((ext_vector_type(4))) unsigned u32x4;
typedef __attribute__((ext_vector_type(2))) unsigned u32x2;
typedef __attribute__((ext_vector_type(4))) float f32x4n;
typedef __attribute__((ext_vector_type(2))) float f32x2n;

constexpr int NLAT = 32768, NCTX = 4096, NROWS = 36864, T = 2304, DFF = 2816;
constexpr float ALPHA = 1.681792830507429f;
constexpr float EPS = 1e-6f;
constexpr float LOG2E = 1.4426950408889634f;

constexpr size_t OFF_MODS = 0;
constexpr size_t OFF_ROPE = OFF_MODS + 1671168;
constexpr size_t OFF_LAM = OFF_ROPE + 8192;
constexpr size_t OFF_WIN_E = OFF_LAM + 256;
constexpr size_t OFF_WIN_O = OFF_WIN_E + 12582912;
constexpr size_t OFF_WO = OFF_WIN_O + 6291456;
constexpr size_t OFF_WUP = OFF_WO + 8388608;
constexpr size_t OFF_WD = OFF_WUP + 46137344;
constexpr size_t OFF_X = OFF_WD + 23068672;
constexpr size_t OFF_H = OFF_X + 75497472;
constexpr size_t OFF_QO = OFF_H + 75497472;
constexpr size_t OFF_K = OFF_QO + 75497472;
constexpr size_t OFF_VT = OFF_K + 75497472;
constexpr size_t OFF_END = OFF_VT + 75497472;
constexpr size_t OFF_ACT = OFF_QO;
constexpr size_t OFF_BAR = OFF_END;
constexpr size_t WS_NEEDED = OFF_BAR + 16384;

constexpr int SMEM_BYTES = 131072 + 4096;
constexpr int NTHR = 512, NWAVE = 8;

struct Params {
  const float *x, *c, *ctx, *c_ctx, *w_ada, *b_ada, *ln_g, *ln_b, *w_in_ab, *w_o_ab, *na_rpb, *diff_lambda, *diff_subln,
      *w_in_c, *w_o_c, *gqa_qk_norm, *w_up, *conv_w, *conv_b, *w_down;
  float* out;
  char* ws;
};

DI unsigned pack2(float a, float b) { f2 v = {a, b}; bf2 r = __builtin_convertvector(v, bf2); return __builtin_bit_cast(unsigned, r); }
DI u16 f2bf(float a) { __bf16 b = (__bf16)a; return __builtin_bit_cast(u16, b); }
DI int crow(int i, int h) { return (i & 3) + 8 * (i >> 2) + 4 * h; }
DI f32x16 mfma32(bf8 a, bf8 b, f32x16 c) { return __builtin_amdgcn_mfma_f32_32x32x16_bf16(a, b, c, 0, 0, 0); }
DI int tid() { int t; asm volatile("v_mov_b32 %0, %1" : "=v"(t) : "v"((int)threadIdx.x)); return t; }
DI int bid() { int b; asm volatile("s_mov_b32 %0, %1" : "=s"(b) : "s"((int)blockIdx.x)); return b; }
typedef __attribute__((address_space(3))) char lds_char;
DI void glds16(const void* gptr, unsigned lds_addr) {
  asm volatile("s_mov_b32 m0, %0\n\ts_nop 0\n\tglobal_load_lds_dwordx4 %1, off" ::"s"(lds_addr), "v"(gptr) : "memory");
}
DI float ex2(float x) { return __builtin_amdgcn_exp2f(x); }
DI float shx(float v, int lane, int mask) { return __int_as_float(__builtin_amdgcn_ds_bpermute((lane ^ mask) << 2, __float_as_int(v))); }
DI float shi(float v, int src) { return __int_as_float(__builtin_amdgcn_ds_bpermute(src << 2, __float_as_int(v))); }
DI float wave_sum(float v, int lane) {
#pragma unroll
  for (int o = 1; o < 64; o <<= 1) v += shx(v, lane, o);
  return v;
}

#define XB_TMO      128
#define XB_XCNT(j)  (256  + 64 * (j))
#define XB_XSUB(j)  (1280 + 64 * (j))
#define XB_XGEN(j)  (2304 + 64 * (j))
#define XB_TOP      3328
#define XB_TOPGEN   3392
#define XCD_BAR_WORDS 3456
#define XB_SPIN_CAP (1u << 18)
#define LAS __attribute__((address_space(3)))
DI unsigned xb_ld(unsigned* p) { return __hip_atomic_load(p, __ATOMIC_RELAXED, __HIP_MEMORY_SCOPE_AGENT); }
DI unsigned xb_add(unsigned* p, unsigned v) { return __hip_atomic_fetch_add(p, v, __ATOMIC_RELAXED, __HIP_MEMORY_SCOPE_AGENT); }
DI unsigned xb_xcc_id() { return (unsigned)__builtin_amdgcn_s_getreg((3 << 11) | 20) & 0xFu; }
#define XB_SPIN(cond, bar) do { unsigned _sp = 0; while (cond) { __builtin_amdgcn_s_sleep(1); \
    if ((++_sp & 255u) == 0u) { if (xb_ld(&(bar)[XB_TMO])) break; if (_sp > XB_SPIN_CAP) { atomicAdd(&(bar)[XB_TMO], 1u); break; } } } } while (0)
struct XcdBarrier { unsigned* bar; unsigned x; volatile LAS unsigned* st; };
DI XcdBarrier xcd_barrier_post(unsigned* bar, volatile LAS unsigned* st) {
  XcdBarrier b; b.bar = bar; b.x = xb_xcc_id(); b.st = st;
  if (threadIdx.x == 0) (void)xb_add(&bar[XB_XCNT(b.x)], 1u);
  return b;
}
DI void xcd_barrier_complete(unsigned* bar, unsigned x, unsigned& nloc, unsigned& nx) {
  const unsigned G = gridDim.x * gridDim.y * gridDim.z;
  unsigned sum, cnt, mine, sp = 0u;
  for (;;) {
    sum = 0u; cnt = 0u; mine = 0u;
#pragma unroll
    for (unsigned j = 0; j < 16; ++j) { const unsigned c = xb_ld(&bar[XB_XCNT(j)]); sum += c; cnt += (c > 0u) ? 1u : 0u; mine = (j == x) ? c : mine; }
    if (sum == G) break;
    __builtin_amdgcn_s_sleep(1);
    if ((++sp & 255u) == 0u) { if (xb_ld(&bar[XB_TMO])) break; if (sp > XB_SPIN_CAP) { atomicAdd(&bar[XB_TMO], 1u); break; } }
  }
  nloc = mine > 0u ? mine : 1u; nx = cnt > 0u ? cnt : 1u;
}
DI void xcd_barrier(const XcdBarrier& b) {
  asm volatile("s_waitcnt vmcnt(0)" ::: "memory");
  __syncthreads();
  if (threadIdx.x == 0) {
    unsigned* bar = b.bar;
    __builtin_amdgcn_s_waitcnt(0);
    unsigned nloc = b.st[0], nx = b.st[1];
    if (nloc == 0u) { xcd_barrier_complete(bar, b.x, nloc, nx); b.st[0] = nloc; b.st[1] = nx; }
    const unsigned old = xb_add(&bar[XB_XSUB(b.x)], 1u);
    const unsigned gen = old / nloc;
    if (old + 1u == (gen + 1u) * nloc) {
      __builtin_amdgcn_fence(__ATOMIC_RELEASE, "agent");
      asm volatile("s_waitcnt vmcnt(0)" ::: "memory");
      const unsigned og = xb_add(&bar[XB_TOP], 1u);
      const unsigned tg = og / nx;
      if (og + 1u == (tg + 1u) * nx) xb_add(&bar[XB_TOPGEN], 1u);
      else XB_SPIN(xb_ld(&bar[XB_TOPGEN]) == tg, bar);
      __builtin_amdgcn_fence(__ATOMIC_ACQUIRE, "agent");
      xb_add(&bar[XB_XGEN(b.x)], 1u);
      asm volatile("s_waitcnt vmcnt(0)" ::: "memory");
    } else {
      XB_SPIN(xb_ld(&bar[XB_XGEN(b.x)]) == gen, bar);
      __builtin_amdgcn_fence(__ATOMIC_ACQUIRE, "agent");
      asm volatile("s_waitcnt vmcnt(0)" ::: "memory");
    }
  }
  __syncthreads();
}

DI void phase0_mods(const Params& p, char* smem) {
  float* condS = (float*)smem;
  float* red = (float*)(smem + 17 * 512 * 4);
  float* mods = (float*)(p.ws + OFF_MODS);
  const int t = tid(), lane = t & 63, w = __builtin_amdgcn_readfirstlane(t >> 6);
  const int cq = t & 15, kg = t >> 4;
  for (int item = bid(); item < 4 * 96; item += gridDim.x) {
    const int l = item / 96, cb = item % 96;
    const int col = cb * 64 + cq * 4;
    float acc[17][4];
#pragma unroll
    for (int i = 0; i < 17; ++i) { acc[i][0] = 0.f; acc[i][1] = 0.f; acc[i][2] = 0.f; acc[i][3] = 0.f; }
    for (int kh = 0; kh < 2; ++kh) {
      __syncthreads();
      for (int e = t; e < 17 * 512; e += NTHR) {
        const int i = e >> 9, k = (e & 511) + kh * 512;
        const float v = (i < 16) ? p.c[i * 1024 + k] : p.c_ctx[k];
        condS[e] = v / (1.f + __expf(-v));
      }
      __syncthreads();
      const float* wp = p.w_ada + ((size_t)l * 1024 + kh * 512 + kg * 16) * 6144 + col;
#pragma unroll 2
      for (int kk = 0; kk < 16; ++kk) {
        const f32x4n wv = *(const f32x4n*)(wp + (size_t)kk * 6144);
#pragma unroll
        for (int i = 0; i < 17; ++i) {
          const float cv = condS[i * 512 + kg * 16 + kk];
          acc[i][0] += cv * wv.x; acc[i][1] += cv * wv.y; acc[i][2] += cv * wv.z; acc[i][3] += cv * wv.w;
        }
      }
    }
#pragma unroll
    for (int i = 0; i < 17; ++i)
#pragma unroll
      for (int j = 0; j < 4; ++j) {
        float v = acc[i][j];
        v += shx(v, lane, 16);
        v += shx(v, lane, 32);
        acc[i][j] = v;
      }
    __syncthreads();
    if (lane < 16) {
#pragma unroll
      for (int i = 0; i < 17; ++i)
#pragma unroll
        for (int j = 0; j < 4; ++j) red[(w * 17 + i) * 64 + cq * 4 + j] = acc[i][j];
    }
    __syncthreads();
    for (int e = t; e < 17 * 64; e += NTHR) {
      const int i = e >> 6, cc = e & 63;
      float s = 0.f;
#pragma unroll
      for (int ww = 0; ww < NWAVE; ++ww) s += red[(ww * 17 + i) * 64 + cc];
      mods[(size_t)(l * 17 + i) * 6144 + cb * 64 + cc] = s + p.b_ada[l * 6144 + cb * 64 + cc];
    }
  }
}

DI void transpose_tile(const float* __restrict__ src, int ldsrc, int k0, int c0, int c1, u16* __restrict__ dst, int lddst, int p0, float* tileS) {
  const int t = tid();
  __syncthreads();
  {
    const int n = t & 63;
    const int col = (n < 32) ? (c0 + n) : (c1 + n - 32);
#pragma unroll
    for (int j = 0; j < 8; ++j) {
      const int kk = (t >> 6) + 8 * j;
      tileS[kk * 65 + n] = src[(size_t)(k0 + kk) * ldsrc + col];
    }
  }
  __syncthreads();
  {
    const int kk2 = (t & 7) * 8;
    const int n2 = t >> 3;
    u32x4 o;
    o.x = pack2(tileS[(kk2 + 0) * 65 + n2], tileS[(kk2 + 1) * 65 + n2]);
    o.y = pack2(tileS[(kk2 + 2) * 65 + n2], tileS[(kk2 + 3) * 65 + n2]);
    o.z = pack2(tileS[(kk2 + 4) * 65 + n2], tileS[(kk2 + 5) * 65 + n2]);
    o.w = pack2(tileS[(kk2 + 6) * 65 + n2], tileS[(kk2 + 7) * 65 + n2]);
    *(u32x4*)(dst + (size_t)(p0 + n2) * lddst + k0 + kk2) = o;
  }
}

DI void phase0_weights(const Params& p, char* smem, int sel) {
  float* tileS = (float*)smem;
  for (int item = bid(); item < 11776; item += gridDim.x) {
    int it = item;
    if (it < 1536) {
      const int i = it / 768, r = it % 768, kt = r / 48, nt = r % 48;
      if ((i == 0) != (sel == 0)) continue;
      transpose_tile(p.w_in_ab + (size_t)i * 1024 * 3072, 3072, kt * 64, nt * 64, nt * 64 + 32,
                     (u16*)(p.ws + OFF_WIN_E) + (size_t)i * 3072 * 1024, 1024, nt * 64, tileS);
      continue;
    }
    it -= 1536;
    if (it < 768) {
      const int i = it / 384, r = it % 384, kt = r / 24, nt = r % 24;
      if (sel == 0) continue;
      transpose_tile(p.w_in_c + (size_t)i * 1024 * 1536, 1536, kt * 64, nt * 64, nt * 64 + 32,
                     (u16*)(p.ws + OFF_WIN_O) + (size_t)i * 1536 * 1024, 1024, nt * 64, tileS);
      continue;
    }
    it -= 768;
    if (it < 1024) {
      const int l = it / 256, r = it % 256, kt = r / 16, nt = r % 16;
      if ((l == 0) != (sel == 0)) continue;
      const float* src = ((l & 1) ? p.w_o_c : p.w_o_ab) + (size_t)(l >> 1) * 1024 * 1024;
      transpose_tile(src, 1024, kt * 64, nt * 64, nt * 64 + 32, (u16*)(p.ws + OFF_WO) + (size_t)l * 1024 * 1024, 1024, nt * 64, tileS);
      continue;
    }
    it -= 1024;
    if (it < 5632) {
      const int l = it / 1408, r = it % 1408, kt = r / 88, pt = r % 88;
      if ((l == 0) != (sel == 0)) continue;
      const int ntile = pt >> 2, wn = pt & 3;
      const int c0 = ntile * 128 + wn * 32;
      transpose_tile(p.w_up + (size_t)l * 1024 * 5632, 5632, kt * 64, c0, c0 + 2816,
                     (u16*)(p.ws + OFF_WUP) + (size_t)l * 5632 * 1024, 1024, pt * 64, tileS);
      continue;
    }
    it -= 5632;
    {
      const int l = it / 704, r = it % 704, kt = r / 16, nt = r % 16;
      if ((l == 0) != (sel == 0)) continue;
      transpose_tile(p.w_down + (size_t)l * 2816 * 1024, 1024, kt * 64, nt * 64, nt * 64 + 32,
                     (u16*)(p.ws + OFF_WD) + (size_t)l * 1024 * 2816, 2816, nt * 64, tileS);
    }
  }
}

DI void phase0_misc(const Params& p) {
  if (bid() != 0) return;
  const int t = tid();
  f32x2n* rope = (f32x2n*)(p.ws + OFF_ROPE);
  for (int e = t; e < 1024; e += NTHR) {
    const int pos = e >> 4, f = e & 15;
    const float inv = ex2(-(float)f * 0.8304820237218406f);
    const float ang = (float)pos * inv;
    rope[e] = f32x2n{__cosf(ang), __sinf(ang)};
  }
  if (t < 2) {
    const float* lv = p.diff_lambda + t * 256;
    float s1 = 0.f, s2 = 0.f;
    for (int k = 0; k < 64; ++k) { s1 += lv[k] * lv[64 + k]; s2 += lv[128 + k] * lv[192 + k]; }
    const float li = (t == 0) ? 0.2f : 0.47071301834358393f;
    ((float*)(p.ws + OFF_LAM))[t] = __expf(s1) - __expf(s2) + li;
  }
}

DI void phase_prep(const Params& p, int l, int which) {
  const int t = tid(), lane = t & 63, w = __builtin_amdgcn_readfirstlane(t >> 6);
  const int rows = (which == 1 && l == 3) ? NLAT : NROWS;
  const bool raw = (which == 0 && l == 0);
  const float* mods = (const float*)(p.ws + OFF_MODS);
  const float* g = raw ? nullptr : (which == 0 ? p.ln_g + ((l - 1) * 2 + 1) * 1024 : p.ln_g + (l * 2) * 1024);
  const float* bb = raw ? nullptr : (which == 0 ? p.ln_b + ((l - 1) * 2 + 1) * 1024 : p.ln_b + (l * 2) * 1024);
  _Float16* X = (_Float16*)(p.ws + OFF_X);
  u16* H = (u16*)(p.ws + OFF_H);
  constexpr int NR = 2;
  const int nwv = gridDim.x * NWAVE;
  for (int Rb = bid() * NWAVE + w; Rb < rows; Rb += nwv * NR) {
    float v[NR][16];
    int RR[NR];
#pragma unroll
    for (int u = 0; u < NR; ++u) {
      const int R0 = Rb + u * nwv;
      RR[u] = R0 < rows ? R0 : Rb;
    }
    if (raw) {
#pragma unroll
      for (int u = 0; u < NR; ++u) {
        const int R = RR[u];
        const float* src = (R < NLAT) ? p.x + (size_t)R * 1024 : p.ctx + (size_t)(R - NLAT) * 1024;
#pragma unroll
        for (int q = 0; q < 2; ++q) {
          const f32x4n a = *(const f32x4n*)(src + q * 512 + lane * 8);
          const f32x4n b = *(const f32x4n*)(src + q * 512 + lane * 8 + 4);
          v[u][q * 8 + 0] = a.x; v[u][q * 8 + 1] = a.y; v[u][q * 8 + 2] = a.z; v[u][q * 8 + 3] = a.w;
          v[u][q * 8 + 4] = b.x; v[u][q * 8 + 5] = b.y; v[u][q * 8 + 6] = b.z; v[u][q * 8 + 7] = b.w;
        }
      }
    } else {
#pragma unroll
      for (int u = 0; u < NR; ++u)
#pragma unroll
        for (int q = 0; q < 2; ++q) {
          const h8 a = *(const h8*)(X + (size_t)RR[u] * 1024 + q * 512 + lane * 8);
#pragma unroll
          for (int j = 0; j < 8; ++j) v[u][q * 8 + j] = (float)a[j];
        }
      float s[NR], mean[NR], s2[NR], rstd[NR];
#pragma unroll
      for (int u = 0; u < NR; ++u) {
        s[u] = 0.f;
#pragma unroll
        for (int j = 0; j < 16; ++j) s[u] += v[u][j];
      }
#pragma unroll
      for (int o = 1; o < 64; o <<= 1)
#pragma unroll
        for (int u = 0; u < NR; ++u) s[u] += shx(s[u], lane, o);
#pragma unroll
      for (int u = 0; u < NR; ++u) {
        mean[u] = s[u] * (1.f / 1024.f);
        s2[u] = 0.f;
#pragma unroll
        for (int j = 0; j < 16; ++j) { const float d = v[u][j] - mean[u]; s2[u] += d * d; }
      }
#pragma unroll
      for (int o = 1; o < 64; o <<= 1)
#pragma unroll
        for (int u = 0; u < NR; ++u) s2[u] += shx(s2[u], lane, o);
#pragma unroll
      for (int u = 0; u < NR; ++u) rstd[u] = rsqrtf(s2[u] * (1.f / 1024.f) + EPS);
#pragma unroll
      for (int q = 0; q < 2; ++q) {
        const int c = q * 512 + lane * 8;
        const f32x4n g0 = *(const f32x4n*)(g + c), g1 = *(const f32x4n*)(g + c + 4);
        const f32x4n b0 = *(const f32x4n*)(bb + c), b1 = *(const f32x4n*)(bb + c + 4);
        const float gg[8] = {g0.x, g0.y, g0.z, g0.w, g1.x, g1.y, g1.z, g1.w};
        const float bv[8] = {b0.x, b0.y, b0.z, b0.w, b1.x, b1.y, b1.z, b1.w};
#pragma unroll
        for (int u = 0; u < NR; ++u)
#pragma unroll
          for (int j = 0; j < 8; ++j) v[u][q * 8 + j] = (v[u][q * 8 + j] - mean[u]) * rstd[u] * gg[j] + bv[j];
      }
    }
#pragma unroll
    for (int u = 0; u < NR; ++u) {
      const int R = RR[u];
      const int mi = (R < NLAT) ? (R >> 11) : 16;
      const float* md = mods + (size_t)(l * 17 + mi) * 6144 + (which == 0 ? 0 : 3 * 1024);
#pragma unroll
      for (int q = 0; q < 2; ++q) {
        const int c = q * 512 + lane * 8;
        h8 xo;
#pragma unroll
        for (int j = 0; j < 8; ++j) xo[j] = (_Float16)v[u][q * 8 + j];
        *(h8*)(X + (size_t)R * 1024 + c) = xo;
        const f32x4n s0 = *(const f32x4n*)(md + c), s1 = *(const f32x4n*)(md + c + 4);
        const f32x4n c0 = *(const f32x4n*)(md + 1024 + c), c1 = *(const f32x4n*)(md + 1024 + c + 4);
        const float sh[8] = {s0.x, s0.y, s0.z, s0.w, s1.x, s1.y, s1.z, s1.w};
        const float sc[8] = {c0.x, c0.y, c0.z, c0.w, c1.x, c1.y, c1.z, c1.w};
        float hv[8];
#pragma unroll
        for (int j = 0; j < 8; ++j) hv[j] = v[u][q * 8 + j] * (1.f + sc[j]) + sh[j];
        u32x4 o;
        o.x = pack2(hv[0], hv[1]); o.y = pack2(hv[2], hv[3]); o.z = pack2(hv[4], hv[5]); o.w = pack2(hv[6], hv[7]);
        *(u32x4*)(H + (size_t)R * 1024 + c) = o;
      }
    }
  }
}

DI void phase_final(const Params& p) {
  const int t = tid(), lane = t & 63, w = __builtin_amdgcn_readfirstlane(t >> 6);
  const float* g = p.ln_g + (3 * 2 + 1) * 1024;
  const float* bb = p.ln_b + (3 * 2 + 1) * 1024;
  const _Float16* X = (const _Float16*)(p.ws + OFF_X);
  constexpr int NR = 2;
  const int nwv = gridDim.x * NWAVE;
  for (int Rb = bid() * NWAVE + w; Rb < NLAT; Rb += nwv * NR) {
    float v[NR][16];
    int RR[NR];
#pragma unroll
    for (int u = 0; u < NR; ++u) { const int R0 = Rb + u * nwv; RR[u] = R0 < NLAT ? R0 : Rb; }
#pragma unroll
    for (int u = 0; u < NR; ++u)
#pragma unroll
      for (int q = 0; q < 2; ++q) {
        const h8 a = *(const h8*)(X + (size_t)RR[u] * 1024 + q * 512 + lane * 8);
#pragma unroll
        for (int j = 0; j < 8; ++j) v[u][q * 8 + j] = (float)a[j];
      }
    float s[NR], mean[NR], s2[NR], rstd[NR];
#pragma unroll
    for (int u = 0; u < NR; ++u) {
      s[u] = 0.f;
#pragma unroll
      for (int j = 0; j < 16; ++j) s[u] += v[u][j];
    }
#pragma unroll
    for (int o = 1; o < 64; o <<= 1)
#pragma unroll
      for (int u = 0; u < NR; ++u) s[u] += shx(s[u], lane, o);
#pragma unroll
    for (int u = 0; u < NR; ++u) {
      mean[u] = s[u] * (1.f / 1024.f);
      s2[u] = 0.f;
#pragma unroll
      for (int j = 0; j < 16; ++j) { const float d = v[u][j] - mean[u]; s2[u] += d * d; }
    }
#pragma unroll
    for (int o = 1; o < 64; o <<= 1)
#pragma unroll
      for (int u = 0; u < NR; ++u) s2[u] += shx(s2[u], lane, o);
#pragma unroll
    for (int u = 0; u < NR; ++u) rstd[u] = rsqrtf(s2[u] * (1.f / 1024.f) + EPS);
#pragma unroll
    for (int q = 0; q < 2; ++q) {
      const int c = q * 512 + lane * 8;
      const f32x4n g0 = *(const f32x4n*)(g + c), g1 = *(const f32x4n*)(g + c + 4);
      const f32x4n b0 = *(const f32x4n*)(bb + c), b1 = *(const f32x4n*)(bb + c + 4);
#pragma unroll
      for (int u = 0; u < NR; ++u) {
        f32x4n o0, o1;
        o0.x = (v[u][q * 8 + 0] - mean[u]) * rstd[u] * g0.x + b0.x; o0.y = (v[u][q * 8 + 1] - mean[u]) * rstd[u] * g0.y + b0.y;
        o0.z = (v[u][q * 8 + 2] - mean[u]) * rstd[u] * g0.z + b0.z; o0.w = (v[u][q * 8 + 3] - mean[u]) * rstd[u] * g0.w + b0.w;
        o1.x = (v[u][q * 8 + 4] - mean[u]) * rstd[u] * g1.x + b1.x; o1.y = (v[u][q * 8 + 5] - mean[u]) * rstd[u] * g1.y + b1.y;
        o1.z = (v[u][q * 8 + 6] - mean[u]) * rstd[u] * g1.z + b1.z; o1.w = (v[u][q * 8 + 7] - mean[u]) * rstd[u] * g1.w + b1.w;
        *(f32x4n*)(p.out + (size_t)RR[u] * 1024 + c) = o0;
        *(f32x4n*)(p.out + (size_t)RR[u] * 1024 + c + 4) = o1;
      }
    }
  }
}

template <int MB, class Epi>
DI void gemm_tile(const u16* __restrict__ A, int lda, int row0, int Mrows, const u16* __restrict__ Bt, int ldb, int K, char* smem, Epi& epi, int rot) {
  char* As = smem;
  char* Bs = smem + 65536;
  const unsigned lds_base = (unsigned)(size_t)(lds_char*)smem;
  const int t = tid(), lane = t & 63, w = __builtin_amdgcn_readfirstlane(t >> 6), wm = w >> 2, wn = w & 3, r = lane & 31, h = lane >> 5;
  constexpr int NAJ = MB;
  const int lr = t >> 3;
  const int lch = (t & 7) ^ ((lr >> 1) & 7);
  unsigned aoff[NAJ];
#pragma unroll
  for (int j = 0; j < NAJ; ++j) {
    int gr = row0 + lr + 64 * j;
    gr = gr < 0 ? 0 : (gr > Mrows - 1 ? Mrows - 1 : gr);
    aoff[j] = (unsigned)gr * (unsigned)lda + lch * 8;
  }
  const u16* bp = Bt + (size_t)lr * ldb + lch * 8;
  f32x16 acc[2][MB];
#pragma unroll
  for (int nb = 0; nb < 2; ++nb)
#pragma unroll
    for (int mb = 0; mb < MB; ++mb)
#pragma unroll
      for (int i = 0; i < 16; ++i) acc[nb][mb][i] = 0.f;
  const int KT = K >> 6;
  int kcur = rot % KT;
#define GEMM_PIECE(STG, PC)                                                                                           \
  {                                                                                                                   \
    if ((PC) < NAJ)                                                                                                   \
      glds16(A + ko_ + aoff[(PC) < NAJ ? (PC) : 0], lds_base + (STG) * 32768 + (w * 64 + 512 * (PC)) * 16);           \
    else if ((PC) < NAJ + 4)                                                                                          \
      glds16(bp + ko_ + (size_t)(64 * ((PC) - NAJ)) * ldb,                                                            \
             lds_base + 65536 + (STG) * 32768 + (w * 64 + 512 * ((PC) - NAJ)) * 16);                                  \
  }
#define GEMM_STAGE(STG)                                                                                               \
  {                                                                                                                   \
    const int ko_ = kcur * 64;                                                                                        \
    _Pragma("unroll") for (int pc = 0; pc < NAJ + 4; ++pc) GEMM_PIECE(STG, pc)                                        \
  }
  GEMM_STAGE(0)
  asm volatile("s_waitcnt vmcnt(0)" ::: "memory");
  __syncthreads();
  const int sw = (r >> 1) & 7;
  int foff[4];
#pragma unroll
  for (int ks = 0; ks < 4; ++ks) foff[ks] = r * 128 + (((2 * ks + h) ^ sw) << 4);
  bf8 af[2][MB], bfr[2][2];
  {
    const char* as0 = As + wm * (32 * MB) * 128;
    const char* bs0 = Bs + wn * 64 * 128;
#pragma unroll
    for (int mb = 0; mb < MB; ++mb) af[0][mb] = *(const bf8*)(as0 + mb * 32 * 128 + foff[0]);
#pragma unroll
    for (int nb = 0; nb < 2; ++nb) bfr[0][nb] = *(const bf8*)(bs0 + nb * 32 * 128 + foff[0]);
  }
  const int kbase = rot % KT;
  if (KT > 1) {
    const int k1_ = (kbase + 1 >= KT) ? kbase + 1 - KT : kbase + 1;
    const int ko_ = k1_ * 64;
#pragma unroll
    for (int pc = 0; pc < 3; ++pc) GEMM_PIECE(1, pc)
  }
  for (int kt = 0; kt < KT; ++kt) {
    const bool more = (kt + 1 < KT);
    const bool more2 = (kt + 2 < KT);
    const int nstg = (kt + 1) & 1;
    const char* as = As + (kt & 1) * 32768 + wm * (32 * MB) * 128;
    const char* bs = Bs + (kt & 1) * 32768 + wn * 64 * 128;
    int k1_ = kbase + kt + 1; if (k1_ >= KT) k1_ -= KT;
    int k2_ = kbase + kt + 2; if (k2_ >= KT) k2_ -= KT; if (k2_ >= KT) k2_ -= KT;
#pragma unroll
    for (int ks = 0; ks < 3; ++ks) {
#pragma unroll
      for (int idx = 0; idx < 2 * MB; ++idx) {
        const int nb = idx / MB, mb = idx % MB;
        acc[nb][mb] = mfma32(bfr[ks & 1][nb], af[ks & 1][mb], acc[nb][mb]);
        if (idx < MB) af[(ks + 1) & 1][idx] = *(const bf8*)(as + idx * 32 * 128 + foff[ks + 1]);
        else if (idx < MB + 2) bfr[(ks + 1) & 1][idx - MB] = *(const bf8*)(bs + (idx - MB) * 32 * 128 + foff[ks + 1]);
        if (more && ks < 2 && idx < 3) {
          const int ko_ = k1_ * 64;
          GEMM_PIECE(nstg, 3 + ks * 3 + idx)
        }
        __builtin_amdgcn_sched_barrier(0);
      }
    }
    if (more) {
      asm volatile("s_waitcnt vmcnt(0)" ::: "memory");
      __syncthreads();
      if (more2) {
        const int ko_ = k2_ * 64;
#pragma unroll
        for (int pc = 0; pc < 3; ++pc) GEMM_PIECE(kt & 1, pc)
      }
      __builtin_amdgcn_sched_barrier(0);
      const char* asn = As + nstg * 32768 + wm * (32 * MB) * 128;
      const char* bsn = Bs + nstg * 32768 + wn * 64 * 128;
#pragma unroll
      for (int mb = 0; mb < MB; ++mb) af[0][mb] = *(const bf8*)(asn + mb * 32 * 128 + foff[0]);
#pragma unroll
      for (int nb = 0; nb < 2; ++nb) bfr[0][nb] = *(const bf8*)(bsn + nb * 32 * 128 + foff[0]);
    }
#pragma unroll
    for (int nb = 0; nb < 2; ++nb)
#pragma unroll
      for (int mb = 0; mb < MB; ++mb) acc[nb][mb] = mfma32(bfr[1][nb], af[1][mb], acc[nb][mb]);
#pragma unroll
    for (int gk = 0; gk < 2 * MB; ++gk) {
      __builtin_amdgcn_sched_group_barrier(0x008, 1, 0);
      __builtin_amdgcn_sched_group_barrier(0x100, 1, 0);
    }
    __builtin_amdgcn_sched_barrier(0);
  }
  __syncthreads();
  epi(acc, wm, wn, r, h);
}

template <int MB>
struct EpiRes {
  _Float16* X; const float* gate; int row0, n0; u16* ostage;
  DI void operator()(f32x16 (&acc)[2][MB], int wm, int wn, int r, int h) {
    u16* slab = ostage + (wm * 4 + wn) * (64 * 72);
    const int lane = h * 32 + r;
#pragma unroll
    for (int mb = 0; mb < MB; ++mb) {
      const int tokl = (mb & 1) * 32 + r;
#pragma unroll
      for (int nb = 0; nb < 2; ++nb)
#pragma unroll
        for (int ig = 0; ig < 4; ++ig) {
          u32x2 o;
          o.x = pack2(acc[nb][mb][ig * 4 + 0], acc[nb][mb][ig * 4 + 1]);
          o.y = pack2(acc[nb][mb][ig * 4 + 2], acc[nb][mb][ig * 4 + 3]);
          *(u32x2*)(slab + tokl * 72 + nb * 32 + ig * 8 + h * 4) = o;
        }
      if ((mb & 1) || mb == MB - 1) {
        asm volatile("s_waitcnt lgkmcnt(0)" ::: "memory");
        const int ntok = (mb & 1) ? 64 : 32;
        const int R0 = row0 + wm * (32 * MB) + (mb >> 1) * 64;
#pragma unroll
        for (int j = 0; j < 8; ++j) {
          const int rowl = (lane >> 3) + 8 * j, ch = lane & 7;
          if (rowl < ntok) {
            const u32x4 yv = *(const u32x4*)(slab + rowl * 72 + ch * 8);
            const int R = R0 + rowl;
            const int mi = (R < NLAT) ? (R >> 11) : 16;
            const int col = n0 + wn * 64 + ch * 8;
            const float* g = gate + (size_t)mi * 6144 + col;
            const f32x4n g0 = *(const f32x4n*)(g), g1 = *(const f32x4n*)(g + 4);
            _Float16* xp = X + (size_t)R * 1024 + col;
            const h8 xv = *(const h8*)xp;
            const float y[8] = {__uint_as_float(yv.x << 16), __uint_as_float(yv.x & 0xffff0000u), __uint_as_float(yv.y << 16), __uint_as_float(yv.y & 0xffff0000u),
                                __uint_as_float(yv.z << 16), __uint_as_float(yv.z & 0xffff0000u), __uint_as_float(yv.w << 16), __uint_as_float(yv.w & 0xffff0000u)};
            const float gg[8] = {g0.x, g0.y, g0.z, g0.w, g1.x, g1.y, g1.z, g1.w};
            h8 o;
#pragma unroll
            for (int q = 0; q < 8; ++q) o[q] = (_Float16)(ALPHA * (float)xv[q] + gg[q] * y[q]);
            *(h8*)xp = o;
          }
        }
      }
    }
    __syncthreads();
  }
};

struct EpiQKV {
  int odd, row0, ntile;
  u16 *QO, *Kb, *VT;
  const f32x2n* rope;
  const float* qkn;
  u16* ostage;
  DI void operator()(f32x16 (&acc)[2][4], int wm, int wn, int r, int h) {
    const int cgi = ntile * 4 + wn;
    u16* slab = ostage + (wm * 4 + wn) * (64 * 72);
    int kind, dst, do_rope, do_norm;
    if (!odd) {
      const int seg = cgi >> 3, idx = cgi & 7;
      kind = seg % 3;
      do_rope = (seg == 3 || seg == 4);
      do_norm = 0;
      if (seg == 0) dst = idx * 64;
      else if (seg == 1) dst = idx;
      else if (seg == 2) dst = idx * 64;
      else if (seg == 3) dst = 512 + idx * 64;
      else if (seg == 4) dst = 8 + idx;
      else dst = 512 + idx * 64;
    } else {
      if (cgi < 16) { kind = 0; dst = cgi * 64; do_rope = 1; do_norm = 1; }
      else if (cgi < 20) { kind = 1; dst = cgi - 16; do_rope = 1; do_norm = 1; }
      else { kind = 2; dst = (cgi - 20) * 64; do_rope = 0; do_norm = 0; }
    }
    const int nkh = odd ? 4 : 16, nvr = odd ? 256 : 1024;
    const float* gn = qkn + (kind == 1 ? 64 : 0);
#pragma unroll
    for (int mb = 0; mb < 4; ++mb) {
      const int R = row0 + wm * 128 + mb * 32 + r;
      const bool lat = R < NLAT;
      const int b = lat ? (R >> 11) : ((R - NLAT) >> 8);
      const int tu = lat ? (R & 2047) : 2048 + ((R - NLAT) & 255);
      float v[2][16];
#pragma unroll
      for (int nb = 0; nb < 2; ++nb)
#pragma unroll
        for (int i = 0; i < 16; ++i) v[nb][i] = acc[nb][mb][i];
      if (do_norm) {
        float ss = 0.f;
#pragma unroll
        for (int nb = 0; nb < 2; ++nb)
#pragma unroll
          for (int i = 0; i < 16; ++i) ss += v[nb][i] * v[nb][i];
        ss += shx(ss, (h * 32 + r), 32);
        const float rs = rsqrtf(ss * (1.f / 64.f) + EPS);
#pragma unroll
        for (int nb = 0; nb < 2; ++nb)
#pragma unroll
          for (int ig = 0; ig < 4; ++ig) {
            const f32x4n gv = *(const f32x4n*)(gn + nb * 32 + ig * 8 + h * 4);
            v[nb][ig * 4 + 0] *= rs * gv.x; v[nb][ig * 4 + 1] *= rs * gv.y;
            v[nb][ig * 4 + 2] *= rs * gv.z; v[nb][ig * 4 + 3] *= rs * gv.w;
          }
      }
      if (do_rope && lat) {
#pragma unroll
        for (int nb = 0; nb < 2; ++nb) {
          const int pos = (nb == 0) ? (tu >> 6) : (tu & 63);
#pragma unroll
          for (int i = 0; i < 8; ++i) {
            const f32x2n cs = rope[pos * 16 + crow(i, h)];
            const float x1 = v[nb][i], x2 = v[nb][i + 8];
            v[nb][i] = x1 * cs.x - x2 * cs.y;
            v[nb][i + 8] = x2 * cs.x + x1 * cs.y;
          }
        }
      }
      const int tokl = (mb & 1) * 32 + r;
      if (kind == 2) {
#pragma unroll
        for (int nb = 0; nb < 2; ++nb)
#pragma unroll
          for (int i = 0; i < 16; ++i) slab[(nb * 32 + crow(i, h)) * 72 + tokl] = f2bf(v[nb][i]);
      } else {
#pragma unroll
        for (int nb = 0; nb < 2; ++nb)
#pragma unroll
          for (int ig = 0; ig < 4; ++ig) {
            u32x2 o;
            o.x = pack2(v[nb][ig * 4 + 0], v[nb][ig * 4 + 1]);
            o.y = pack2(v[nb][ig * 4 + 2], v[nb][ig * 4 + 3]);
            *(u32x2*)(slab + tokl * 72 + nb * 32 + ig * 8 + h * 4) = o;
          }
      }
      if (mb & 1) {
        asm volatile("s_waitcnt lgkmcnt(0)" ::: "memory");
        const int lane = h * 32 + r;
        const int R0 = row0 + wm * 128 + (mb >> 1) * 64;
        const bool lat0 = R0 < NLAT;
        const int b0 = lat0 ? (R0 >> 11) : ((R0 - NLAT) >> 8);
        const int tu0 = lat0 ? (R0 & 2047) : 2048 + ((R0 - NLAT) & 255);
#pragma unroll
        for (int j = 0; j < 8; ++j) {
          const int rowl = (lane >> 3) + 8 * j, ch = lane & 7;
          const u32x4 val = *(const u32x4*)(slab + rowl * 72 + ch * 8);
          u16* dp;
          if (kind == 2) dp = VT + ((size_t)b0 * nvr + dst + rowl) * T + tu0 + ch * 8;
          else if (kind == 0) dp = QO + (size_t)(R0 + rowl) * 1024 + dst + ch * 8;
          else dp = Kb + (((size_t)b0 * nkh + dst) * T + tu0 + rowl) * 64 + ch * 8;
          *(u32x4*)dp = val;
        }
      }
    }
    __syncthreads();
  }
};

DI float gelu_tanh(float g) {
  const float u = g * g;
  const float t = g * (-2.302208198f - 0.1029432397f * u);
  const float e = ex2(t);
  return g * __builtin_amdgcn_rcpf(1.f + e);
}

struct EpiUp {
  u16* act; const float* cw; const float* cb; int row0, Mrows, nt; float* edge; u16* ostage;
  DI void operator()(f32x16 (&acc)[2][4], int wm, int wn, int r, int h) {
    float* eb = edge + ((wm * 4 + wn) * 2) * 64;
    if (r == 0) {
#pragma unroll
      for (int nb = 0; nb < 2; ++nb)
#pragma unroll
        for (int i = 0; i < 16; ++i) eb[nb * 32 + crow(i, h)] = acc[nb][0][i];
    }
    if (r == 31) {
#pragma unroll
      for (int nb = 0; nb < 2; ++nb)
#pragma unroll
        for (int i = 0; i < 16; ++i) eb[64 + nb * 32 + crow(i, h)] = acc[nb][3][i];
    }
    __syncthreads();
    const float* ob = edge + (((wm ^ 1) * 4 + wn) * 2) * 64 + (wm == 0 ? 0 : 64);
    const int sp = (h << 5) | ((r - 1) & 31), sn = (h << 5) | ((r + 1) & 31);
    const int Rb = row0 + wm * 128 + r;
    u16* ost = ostage + (wm * 4 + wn) * (128 * 40);
    float pm[4], nm[4];
#pragma unroll
    for (int mb = 0; mb < 4; ++mb) {
      const int R = Rb + mb * 32;
      const bool lat = R < NLAT;
      const int tt = lat ? (R & 2047) : ((R - NLAT) & 255);
      pm[mb] = (tt == 0) ? 0.f : 1.f;
      nm[mb] = (tt == (lat ? 2047 : 255)) ? 0.f : 1.f;
    }
#pragma unroll
    for (int ig = 0; ig < 4; ++ig)
#pragma unroll
      for (int qp = 0; qp < 2; ++qp) {
        const int i0 = ig * 4 + qp * 2;
        float u[2][4][2];
#pragma unroll
        for (int nb = 0; nb < 2; ++nb) {
          int xp[4];
#pragma unroll
          for (int mb = 0; mb < 4; ++mb) xp[mb] = (int)pack2(acc[nb][mb][i0], acc[nb][mb][i0 + 1]);
          const float eo0 = ob[nb * 32 + crow(i0, h)], eo1 = ob[nb * 32 + crow(i0 + 1, h)];
          float w0[2], w1[2], w2[2], bz[2];
          {
            const int ff = nt * 128 + wn * 32 + crow(i0, h) + nb * DFF;
            const f32x2n a0 = *(const f32x2n*)(cw + ff), a1 = *(const f32x2n*)(cw + 2 * DFF + ff), a2 = *(const f32x2n*)(cw + 4 * DFF + ff),
                         a3 = *(const f32x2n*)(cb + ff);
            w0[0] = a0.x; w0[1] = a0.y; w1[0] = a1.x; w1[1] = a1.y; w2[0] = a2.x; w2[1] = a2.y; bz[0] = a3.x; bz[1] = a3.y;
          }
          int spm = 0;
#pragma unroll
          for (int mb = 0; mb < 4; ++mb) {
            const int spc = __builtin_amdgcn_ds_bpermute(sp << 2, xp[mb]);
            const int snc = __builtin_amdgcn_ds_bpermute(sn << 2, xp[mb]);
            const int snn = (mb < 3) ? __builtin_amdgcn_ds_bpermute(sn << 2, xp[mb < 3 ? mb + 1 : 3]) : 0;
            const int pv = (mb > 0) ? ((r == 0) ? spm : spc) : spc;
            const int nv = (mb < 3) ? ((r == 31) ? snn : snc) : snc;
            float prev0 = __int_as_float(pv << 16), prev1 = __int_as_float(pv & 0xffff0000);
            float next0 = __int_as_float(nv << 16), next1 = __int_as_float(nv & 0xffff0000);
            if (mb == 0 && r == 0) { prev0 = eo0; prev1 = eo1; }
            if (mb == 3 && r == 31) { next0 = eo0; next1 = eo1; }
            spm = spc;
            prev0 *= pm[mb]; prev1 *= pm[mb];
            next0 *= nm[mb]; next1 *= nm[mb];
            u[nb][mb][0] = w0[0] * prev0 + w1[0] * acc[nb][mb][i0] + w2[0] * next0 + bz[0];
            u[nb][mb][1] = w0[1] * prev1 + w1[1] * acc[nb][mb][i0 + 1] + w2[1] * next1 + bz[1];
          }
        }
#pragma unroll
        for (int mb = 0; mb < 4; ++mb)
          *(unsigned*)(ost + (mb * 32 + r) * 40 + ig * 8 + h * 4 + qp * 2) =
              pack2(gelu_tanh(u[1][mb][0]) * u[0][mb][0], gelu_tanh(u[1][mb][1]) * u[0][mb][1]);
      }
    asm volatile("s_waitcnt lgkmcnt(0)" ::: "memory");
    const int lane = h * 32 + r;
#pragma unroll
    for (int j = 0; j < 8; ++j) {
      const int tk = (lane >> 2) + 16 * j, ch = lane & 3;
      const int tr = wm * 128 + tk;
      const int R = row0 + tr;
      const u32x4 v = *(const u32x4*)(ost + tk * 40 + ch * 8);
      if ((tr >= 1) && (tr <= 254) && (R >= 0) && (R < Mrows))
        *(u32x4*)(act + (size_t)R * DFF + nt * 128 + wn * 32 + ch * 8) = v;
    }
    __syncthreads();
  }
};

DI bool tile_map(int id, int NT, int MT, int& mt, int& nt) {
  const int x = id & 7, q = id >> 3;
  nt = q % NT;
  mt = (q / NT) * 8 + x;
  return mt < MT;
}

DI void phase_qkv(const Params& p, int l, char* smem) {
  const int odd = l & 1;
  const int NT = odd ? 6 : 12;
  const u16* W = odd ? (const u16*)(p.ws + OFF_WIN_O) + (size_t)(l >> 1) * 1536 * 1024 : (const u16*)(p.ws + OFF_WIN_E) + (size_t)(l >> 1) * 3072 * 1024;
  const u16* H = (const u16*)(p.ws + OFF_H);
  for (int tile = bid(); tile < 144 * NT; tile += gridDim.x) {
    int mt, nt;
    if (!tile_map(tile, NT, 144, mt, nt)) continue;
    if (l == 3 && mt >= 128 && nt < 4) continue;
    EpiQKV e;
    e.odd = odd; e.row0 = mt * 256; e.ntile = nt;
    e.QO = (u16*)(p.ws + OFF_QO); e.Kb = (u16*)(p.ws + OFF_K); e.VT = (u16*)(p.ws + OFF_VT);
    e.rope = (const f32x2n*)(p.ws + OFF_ROPE);
    e.qkn = p.gqa_qk_norm + (l >> 1) * 128;
    e.ostage = (u16*)smem;
    gemm_tile<4>(H, 1024, mt * 256, NROWS, W + (size_t)nt * 256 * 1024, 1024, 1024, smem, e, tile);
  }
}

struct EpiNull {
  float* sink;
  DI void operator()(f32x16 (&acc)[2][4], int wm, int wn, int r, int h) {
    float s = 0.f;
#pragma unroll
    for (int nb = 0; nb < 2; ++nb)
#pragma unroll
      for (int mb = 0; mb < 4; ++mb)
#pragma unroll
        for (int i = 0; i < 16; ++i) s += acc[nb][mb][i];
    if (s == 123.456f) *sink = s;
  }
};
DI void phase_qkv_null(const Params& p, int l, char* smem) {
  const int odd = l & 1;
  const int NT = odd ? 6 : 12;
  const u16* W = odd ? (const u16*)(p.ws + OFF_WIN_O) + (size_t)(l >> 1) * 1536 * 1024 : (const u16*)(p.ws + OFF_WIN_E) + (size_t)(l >> 1) * 3072 * 1024;
  const u16* H = (const u16*)(p.ws + OFF_H);
  for (int tile = bid(); tile < 144 * NT; tile += gridDim.x) {
    int mt, nt;
    if (!tile_map(tile, NT, 144, mt, nt)) continue;
    EpiNull e;
    e.sink = (float*)(p.ws + OFF_LAM + 64);
    gemm_tile<4>(H, 1024, mt * 256, NROWS, W + (size_t)nt * 256 * 1024, 1024, 1024, smem, e, tile);
  }
}

template <int MB>
DI void phase_res_t(const Params& p, int l, int which, char* smem) {
  constexpr int TR = 64 * MB;
  const int rows = (l == 3) ? NLAT : NROWS;
  const int MT = rows / TR;
  const u16* A = which ? (const u16*)(p.ws + OFF_ACT) : (const u16*)(p.ws + OFF_QO);
  const int lda = which ? DFF : 1024, K = which ? DFF : 1024;
  const u16* W = which ? (const u16*)(p.ws + OFF_WD) + (size_t)l * 1024 * DFF : (const u16*)(p.ws + OFF_WO) + (size_t)l * 1024 * 1024;
  const float* gate = (const float*)(p.ws + OFF_MODS) + (size_t)l * 17 * 6144 + (which ? 5 : 2) * 1024;
  for (int tile = bid(); tile < MT * 4; tile += gridDim.x) {
    int mt, nt;
    if (!tile_map(tile, 4, MT, mt, nt)) continue;
    EpiRes<MB> e;
    e.X = (_Float16*)(p.ws + OFF_X); e.gate = gate; e.row0 = mt * TR; e.n0 = nt * 256; e.ostage = (u16*)smem;
    gemm_tile<MB>(A, lda, mt * TR, rows, W + (size_t)nt * 256 * K, K, K, smem, e, tile);
  }
}
DI void phase_res(const Params& p, int l, int which, char* smem) {
  if (l == 3) phase_res_t<4>(p, l, which, smem);
  else phase_res_t<3>(p, l, which, smem);
}

DI void phase_up(const Params& p, int l, char* smem) {
  const int rows = (l == 3) ? NLAT : NROWS;
  const int MT = (rows + 253) / 254;
  const int MTP = (MT + 7) & ~7;
  const u16* W = (const u16*)(p.ws + OFF_WUP) + (size_t)l * 5632 * 1024;
  const u16* H = (const u16*)(p.ws + OFF_H);
  for (int tile = bid(); tile < MTP * 22; tile += gridDim.x) {
    int mt, nt;
    if (!tile_map(tile, 22, MT, mt, nt)) continue;
    EpiUp e;
    e.act = (u16*)(p.ws + OFF_ACT); e.cw = p.conv_w + (size_t)l * 3 * 5632; e.cb = p.conv_b + (size_t)l * 5632;
    e.row0 = mt * 254 - 1; e.Mrows = rows; e.nt = nt; e.edge = (float*)(smem + 131072); e.ostage = (u16*)smem;
    gemm_tile<4>(H, 1024, mt * 254 - 1, rows, W + (size_t)nt * 256 * 1024, 1024, 1024, smem, e, tile);
  }
}

struct AttnArgs {
  u16* qo;
  const u16 *k1, *k2, *vt;
  int s0, n0, n1;
  const float* rpb;
  int rq0, us;
  float lam, oml;
  const float* subln;
};

template <int DV, int MODE>
DI void attn_item(const AttnArgs& a, char* smem) {
  u16* Ks1 = (u16*)smem;
  u16* Ks2 = (u16*)(smem + 9216);
  u16* Vs = (u16*)(smem + 18432);
  float* rpbS = (float*)(smem + 36864);
  const int t = tid(), lane = t & 63, w = __builtin_amdgcn_readfirstlane(t >> 6), r = lane & 31, h = lane >> 5;
  constexpr int NDV = DV / 32;
  constexpr int NVL = DV / 64;
  const int nt = a.n0 + a.n1;

  const int qrow = (MODE == 1) ? ((w & 3) * 32 + r) : (w * 32 + r);
  const int qcoff = (MODE == 1) ? ((w >> 2) * 64) : 0;
  u16* qp = a.qo + (size_t)qrow * 1024;
  bf8 qf[4];
#pragma unroll
  for (int ks = 0; ks < 4; ++ks) qf[ks] = *(const bf8*)(qp + qcoff + ks * 16 + h * 8);
  const u16* Ks = (MODE == 1 && (w >> 2)) ? Ks2 : Ks1;

  int rq = 0, qc = 0, cs = 0, rsw = 0;
  if (MODE == 2) {
    __syncthreads();
    for (int e = t; e < 15 * 32; e += NTHR) {
      const int dr = e >> 5, dc = e & 31;
      rpbS[e] = (dc < 31) ? a.rpb[dr * 31 + dc] * LOG2E : 0.f;
    }
    rq = a.rq0 + (w >> 1);
    qc = (w & 1) * 32 + r;
    cs = qc - 8; cs = cs < 0 ? 0 : (cs > 48 ? 48 : cs);
    rsw = rq - 4; rsw = rsw < 0 ? 0 : (rsw > 24 ? 24 : rsw);
  }

  f32x16 O[NDV];
#pragma unroll
  for (int d = 0; d < NDV; ++d)
#pragma unroll
    for (int i = 0; i < 16; ++i) O[d][i] = 0.f;
  float m = -1e30f, lsum = 0.f;

  u32x4 rk1, rk2, rv[NVL];
  const int srow = t >> 3, sch = t & 7;
#define ATTN_FETCH(TT)                                                                                         \
  {                                                                                                            \
    const int tt_ = (TT);                                                                                      \
    const int key0_ = tt_ < a.n0 ? a.s0 + tt_ * 64 : 2048 + (tt_ - a.n0) * 64;                                 \
    rk1 = *(const u32x4*)(a.k1 + (size_t)(key0_ + srow) * 64 + sch * 8);                                       \
    if (MODE == 1) rk2 = *(const u32x4*)(a.k2 + (size_t)(key0_ + srow) * 64 + sch * 8);                        \
    _Pragma("unroll") for (int j = 0; j < NVL; ++j)                                                            \
        rv[j] = *(const u32x4*)(a.vt + (size_t)(srow + 64 * j) * T + key0_ + sch * 8);                         \
  }
  if (nt > 0) ATTN_FETCH(0)
  for (int tt = 0; tt < nt; ++tt) {
    __syncthreads();
    *(u32x4*)(Ks1 + srow * 72 + sch * 8) = rk1;
    if (MODE == 1) *(u32x4*)(Ks2 + srow * 72 + sch * 8) = rk2;
#pragma unroll
    for (int j = 0; j < NVL; ++j) *(u32x4*)(Vs + (srow + 64 * j) * 72 + sch * 8) = rv[j];
    __syncthreads();
    if (tt + 1 < nt) ATTN_FETCH(tt + 1)
    __builtin_amdgcn_sched_barrier(0);

    bool active = true;
    int kr = 0;
    const bool local = (MODE == 2) && (tt < a.n0);
    if (local) { kr = a.us + tt; active = (kr >= rsw) && (kr < rsw + 8); }
    if (active) {
      f32x16 s[2];
#pragma unroll
      for (int kb = 0; kb < 2; ++kb) {
#pragma unroll
        for (int i = 0; i < 16; ++i) s[kb][i] = 0.f;
#pragma unroll
        for (int ks = 0; ks < 4; ++ks) {
          const bf8 kf = *(const bf8*)(Ks + (kb * 32 + r) * 72 + ks * 16 + h * 8);
          s[kb] = mfma32(kf, qf[ks], s[kb]);
        }
      }
      constexpr float SC = 0.125f * LOG2E;
      float mx = -INFINITY;
      if (local) {
#pragma unroll
        for (int kb = 0; kb < 2; ++kb)
#pragma unroll
          for (int i = 0; i < 16; ++i) {
            const int kc = kb * 32 + crow(i, h);
            const bool ok = (kc >= cs) && (kc < cs + 16);
            const int dc = kc - qc + 15;
            const int dr = kr - rq + 7;
            const float bias = rpbS[dr * 32 + (ok ? dc : 0)];
            const float v = ok ? (s[kb][i] + bias * (1.f / SC)) : -INFINITY;
            s[kb][i] = v;
            mx = fmaxf(mx, v);
          }
      } else {
#pragma unroll
        for (int kb = 0; kb < 2; ++kb)
#pragma unroll
          for (int i = 0; i < 16; i += 2) mx = fmaxf(fmaxf(mx, s[kb][i]), s[kb][i + 1]);
      }
      mx = fmaxf(mx, shx(mx, lane, 32)) * SC;
      const float mn = fmaxf(m, mx);
      const bool resc = __builtin_amdgcn_ballot_w64(mn != m) != 0ull;
      float ps0 = 0.f, ps1 = 0.f;
#pragma unroll
      for (int kb = 0; kb < 2; ++kb)
#pragma unroll
        for (int i = 0; i < 16; i += 2) {
          f32x2n v = {s[kb][i], s[kb][i + 1]};
          v = v * f32x2n{SC, SC} - f32x2n{mn, mn};
          const float p0 = ex2(v.x), p1 = ex2(v.y);
          s[kb][i] = p0; s[kb][i + 1] = p1;
          ps0 += p0; ps1 += p1;
        }
      if (resc) {
        const float alpha = ex2(m - mn);
        m = mn;
        lsum *= alpha;
#pragma unroll
        for (int d = 0; d < NDV; ++d)
#pragma unroll
          for (int i = 0; i < 16; ++i) O[d][i] *= alpha;
      }
      lsum += ps0 + ps1;
#pragma unroll
      for (int kb = 0; kb < 2; ++kb)
#pragma unroll
        for (int s2 = 0; s2 < 2; ++s2) {
          u32x4 pk;
          pk.x = pack2(s[kb][s2 * 8 + 0], s[kb][s2 * 8 + 1]);
          pk.y = pack2(s[kb][s2 * 8 + 2], s[kb][s2 * 8 + 3]);
          pk.z = pack2(s[kb][s2 * 8 + 4], s[kb][s2 * 8 + 5]);
          pk.w = pack2(s[kb][s2 * 8 + 6], s[kb][s2 * 8 + 7]);
          const bf8 pf = __builtin_bit_cast(bf8, pk);
#pragma unroll
          for (int d = 0; d < NDV; ++d) {
            const u16* vp = Vs + (d * 32 + r) * 72 + kb * 32 + s2 * 16 + 4 * h;
            u32x4 vv;
            const u32x2 lo = *(const u32x2*)(vp);
            const u32x2 hi = *(const u32x2*)(vp + 8);
            vv.x = lo.x; vv.y = lo.y; vv.z = hi.x; vv.w = hi.y;
            O[d] = mfma32(__builtin_bit_cast(bf8, vv), pf, O[d]);
          }
        }
    }
  }
  const float ltot = lsum + shx(lsum, lane, 32);
  const float inv = 1.f / ltot;
  if (MODE != 1) {
#pragma unroll
    for (int d = 0; d < NDV; ++d)
#pragma unroll
      for (int ig = 0; ig < 4; ++ig) {
        u32x2 o;
        o.x = pack2(O[d][ig * 4 + 0] * inv, O[d][ig * 4 + 1] * inv);
        o.y = pack2(O[d][ig * 4 + 2] * inv, O[d][ig * 4 + 3] * inv);
        *(u32x2*)(qp + d * 32 + ig * 8 + h * 4) = o;
      }
  } else {
    float* comb = (float*)smem;
    __syncthreads();
    if (w >= 4) {
#pragma unroll
      for (int d = 0; d < NDV; ++d)
#pragma unroll
        for (int i = 0; i < 16; ++i) comb[((w - 4) * 128 + d * 32 + crow(i, h)) * 32 + r] = O[d][i] * inv;
    }
    __syncthreads();
    if (w < 4) {
      float ss = 0.f;
#pragma unroll
      for (int d = 0; d < NDV; ++d)
#pragma unroll
        for (int i = 0; i < 16; ++i) {
          const float o = O[d][i] * inv - a.lam * comb[(w * 128 + d * 32 + crow(i, h)) * 32 + r];
          O[d][i] = o;
          ss += o * o;
        }
      ss += shx(ss, lane, 32);
      const float rs = rsqrtf(ss * (1.f / 128.f) + EPS) * a.oml;
#pragma unroll
      for (int d = 0; d < NDV; ++d)
#pragma unroll
        for (int ig = 0; ig < 4; ++ig) {
          const f32x4n gv = *(const f32x4n*)(a.subln + d * 32 + ig * 8 + h * 4);
          u32x2 o;
          o.x = pack2(O[d][ig * 4 + 0] * rs * gv.x, O[d][ig * 4 + 1] * rs * gv.y);
          o.y = pack2(O[d][ig * 4 + 2] * rs * gv.z, O[d][ig * 4 + 3] * rs * gv.w);
          *(u32x2*)(qp + d * 32 + ig * 8 + h * 4) = o;
        }
    }
  }
}

DI void attn_item_q64(const AttnArgs& a, char* smem) {
  char* Kb_ = smem;
  char* Vb_ = smem + 16384;
  const unsigned lds_base = (unsigned)(size_t)(lds_char*)smem;
  const int t = tid(), lane = t & 63, w = __builtin_amdgcn_readfirstlane(t >> 6), r = lane & 31, h = lane >> 5;
  const int nt = a.n0 + a.n1;
  u16* qp[2];
  bf8 qf[2][4];
#pragma unroll
  for (int q2 = 0; q2 < 2; ++q2) {
    qp[q2] = a.qo + (size_t)(w * 64 + q2 * 32 + r) * 1024;
#pragma unroll
    for (int ks = 0; ks < 4; ++ks) qf[q2][ks] = *(const bf8*)(qp[q2] + ks * 16 + h * 8);
  }
  f32x16 O[2][2];
#pragma unroll
  for (int q2 = 0; q2 < 2; ++q2)
#pragma unroll
    for (int d = 0; d < 2; ++d)
#pragma unroll
      for (int i = 0; i < 16; ++i) O[q2][d][i] = 0.f;
  float m[2] = {-1e30f, -1e30f}, lsum[2] = {0.f, 0.f};
  const int srow = t >> 3, sch = (t & 7) ^ ((srow >> 1) & 7);
  const u16* kg = a.k1 + (size_t)srow * 64 + sch * 8;
  const u16* vg = a.vt + (size_t)srow * T + sch * 8;
#define ATTN2_ISSUE(TT, BUF)                                                                                   \
  {                                                                                                            \
    const int tt_ = (TT) < nt ? (TT) : nt - 1;                                                                 \
    const int key0_ = tt_ < a.n0 ? a.s0 + tt_ * 64 : 2048 + (tt_ - a.n0) * 64;                                 \
    glds16(kg + (size_t)key0_ * 64, lds_base + (BUF) * 8192 + w * 1024);                                       \
    glds16(vg + key0_, lds_base + 16384 + (BUF) * 8192 + w * 1024);                                            \
  }
  __syncthreads();
  ATTN2_ISSUE(0, 0)
  ATTN2_ISSUE(1, 1)
  asm volatile("s_waitcnt vmcnt(2)" ::: "memory");
  __syncthreads();
  const int sw = (r >> 1) & 7;
  int koff[4];
#pragma unroll
  for (int ks = 0; ks < 4; ++ks) koff[ks] = r * 128 + (((2 * ks + h) ^ sw) << 4);
  for (int tt = 0; tt < nt; ++tt) {
    const char* Ks = Kb_ + (tt & 1) * 8192;
    const char* Vs = Vb_ + (tt & 1) * 8192;
    f32x16 s[2][2];
#pragma unroll
    for (int kb = 0; kb < 2; ++kb) {
#pragma unroll
      for (int q2 = 0; q2 < 2; ++q2)
#pragma unroll
        for (int i = 0; i < 16; ++i) s[q2][kb][i] = 0.f;
#pragma unroll
      for (int ks = 0; ks < 4; ++ks) {
        const bf8 kf = *(const bf8*)(Ks + kb * 32 * 128 + koff[ks]);
#pragma unroll
        for (int q2 = 0; q2 < 2; ++q2) s[q2][kb] = mfma32(kf, qf[q2][ks], s[q2][kb]);
      }
    }
    constexpr float SC = 0.125f * LOG2E;
#pragma unroll
    for (int q2 = 0; q2 < 2; ++q2) {
      float mx = -INFINITY;
#pragma unroll
      for (int kb = 0; kb < 2; ++kb)
#pragma unroll
        for (int i = 0; i < 16; i += 2) mx = fmaxf(fmaxf(mx, s[q2][kb][i]), s[q2][kb][i + 1]);
      mx = fmaxf(mx, shx(mx, lane, 32)) * SC;
      const float mn = fmaxf(m[q2], mx);
      const bool resc = __builtin_amdgcn_ballot_w64(mn != m[q2]) != 0ull;
      float ps0 = 0.f, ps1 = 0.f;
#pragma unroll
      for (int kb = 0; kb < 2; ++kb)
#pragma unroll
        for (int i = 0; i < 16; i += 2) {
          f32x2n v = {s[q2][kb][i], s[q2][kb][i + 1]};
          v = v * f32x2n{SC, SC} - f32x2n{mn, mn};
          const float p0 = ex2(v.x), p1 = ex2(v.y);
          s[q2][kb][i] = p0; s[q2][kb][i + 1] = p1;
          ps0 += p0; ps1 += p1;
        }
      if (resc) {
        const float alpha = ex2(m[q2] - mn);
        m[q2] = mn;
        lsum[q2] *= alpha;
#pragma unroll
        for (int d = 0; d < 2; ++d)
#pragma unroll
          for (int i = 0; i < 16; ++i) O[q2][d][i] *= alpha;
      }
      lsum[q2] += ps0 + ps1;
    }
#pragma unroll
    for (int kb = 0; kb < 2; ++kb)
#pragma unroll
      for (int s2 = 0; s2 < 2; ++s2) {
        const int kk = kb * 2 + s2;
        bf8 pf[2];
#pragma unroll
        for (int q2 = 0; q2 < 2; ++q2) {
          u32x4 pk;
          pk.x = pack2(s[q2][kb][s2 * 8 + 0], s[q2][kb][s2 * 8 + 1]);
          pk.y = pack2(s[q2][kb][s2 * 8 + 2], s[q2][kb][s2 * 8 + 3]);
          pk.z = pack2(s[q2][kb][s2 * 8 + 4], s[q2][kb][s2 * 8 + 5]);
          pk.w = pack2(s[q2][kb][s2 * 8 + 6], s[q2][kb][s2 * 8 + 7]);
          pf[q2] = __builtin_bit_cast(bf8, pk);
        }
#pragma unroll
        for (int d = 0; d < 2; ++d) {
          const char* vrow = Vs + (d * 32 + r) * 128 + 8 * h;
          u32x4 vv;
          const u32x2 lo = *(const u32x2*)(vrow + (((2 * kk) ^ sw) << 4));
          const u32x2 hi = *(const u32x2*)(vrow + (((2 * kk + 1) ^ sw) << 4));
          vv.x = lo.x; vv.y = lo.y; vv.z = hi.x; vv.w = hi.y;
          const bf8 vf = __builtin_bit_cast(bf8, vv);
#pragma unroll
          for (int q2 = 0; q2 < 2; ++q2) O[q2][d] = mfma32(vf, pf[q2], O[q2][d]);
        }
      }
    asm volatile("s_waitcnt vmcnt(0)" ::: "memory");
    __syncthreads();
    if (tt + 2 < nt) ATTN2_ISSUE(tt + 2, tt & 1)
  }
#pragma unroll
  for (int q2 = 0; q2 < 2; ++q2) {
    const float ltot = lsum[q2] + shx(lsum[q2], lane, 32);
    const float inv = 1.f / ltot;
#pragma unroll
    for (int d = 0; d < 2; ++d)
#pragma unroll
      for (int ig = 0; ig < 4; ++ig) {
        u32x2 o;
        o.x = pack2(O[q2][d][ig * 4 + 0] * inv, O[q2][d][ig * 4 + 1] * inv);
        o.y = pack2(O[q2][d][ig * 4 + 2] * inv, O[q2][d][ig * 4 + 3] * inv);
        *(u32x2*)(qp[q2] + d * 32 + ig * 8 + h * 4) = o;
      }
  }
}

DI void phase_attn(const Params& p, int l, char* smem) {
  u16* QO = (u16*)(p.ws + OFF_QO);
  const u16* Kb = (const u16*)(p.ws + OFF_K);
  const u16* VT = (const u16*)(p.ws + OFF_VT);
  const bool need_ctx = l < 3;
  if (l & 1) {
    const int total = 1024 + (need_ctx ? 256 : 0);
    for (int id = bid(); id < total; id += gridDim.x) {
      AttnArgs a;
      a.k2 = nullptr; a.rpb = nullptr; a.rq0 = 0; a.us = 0; a.lam = 0.f; a.oml = 0.f; a.subln = nullptr;
      if (id < 1024) {
        const int x = id & 7, q = id >> 3, within = q & 15, g = (q >> 4) * 8 + x;
        const int b = g >> 2, kvh = g & 3, hq = kvh * 4 + (within >> 2), qb = within & 3;
        a.qo = QO + (size_t)(b * 2048 + qb * 512) * 1024 + hq * 64;
        a.k1 = Kb + ((size_t)b * 4 + kvh) * T * 64;
        a.vt = VT + ((size_t)b * 256 + kvh * 64) * T;
        a.s0 = 0; a.n0 = 32; a.n1 = 4;
        attn_item_q64(a, smem);
        continue;
      } else {
        const int id2 = id - 1024;
        const int hq = id2 & 15, b = id2 >> 4, kvh = hq >> 2;
        a.qo = QO + (size_t)(NLAT + b * 256) * 1024 + hq * 64;
        a.k1 = Kb + ((size_t)b * 4 + kvh) * T * 64;
        a.vt = VT + ((size_t)b * 256 + kvh * 64) * T;
        a.s0 = 0; a.n0 = 0; a.n1 = 4;
      }
      attn_item<64, 0>(a, smem);
    }
  } else {
    const int li = l >> 1;
    const float lam = ((const float*)(p.ws + OFF_LAM))[li];
    const float oml = 1.f - ((li == 0) ? 0.2f : 0.47071301834358393f);
    const int total = 1024 + 1024 + (need_ctx ? 128 + 128 : 0);
    for (int id = bid(); id < total; id += gridDim.x) {
      AttnArgs a;
      a.k2 = nullptr; a.rpb = nullptr; a.rq0 = 0; a.us = 0; a.lam = lam; a.oml = oml; a.subln = p.diff_subln + li * 128;
      if (id < 1024) {
        const int x = id & 7, q = id >> 3, qb = q & 15, g = (q >> 4) * 8 + x;
        const int b = g >> 2, j = g & 3;
        a.qo = QO + (size_t)(b * 2048 + qb * 128) * 1024 + 512 + j * 128;
        a.k1 = Kb + ((size_t)b * 16 + 8 + 2 * j) * T * 64;
        a.k2 = Kb + ((size_t)b * 16 + 8 + 2 * j + 1) * T * 64;
        a.vt = VT + ((size_t)b * 1024 + 512 + j * 128) * T;
        a.s0 = 0; a.n0 = 32; a.n1 = 4;
        attn_item<128, 1>(a, smem);
      } else if (id < 2048) {
        const int id2 = id - 1024;
        const int x = id2 & 7, q = id2 >> 3, pr = q & 7, g = (q >> 3) * 8 + x;
        const int b = g >> 3, hd = g & 7;
        const int r0 = 4 * pr;
        int rs0 = r0 - 4; rs0 = rs0 < 0 ? 0 : (rs0 > 24 ? 24 : rs0);
        int rs3 = r0 - 1; rs3 = rs3 < 0 ? 0 : (rs3 > 24 ? 24 : rs3);
        a.qo = QO + (size_t)(b * 2048 + r0 * 64) * 1024 + hd * 64;
        a.k1 = Kb + ((size_t)b * 16 + hd) * T * 64;
        a.vt = VT + ((size_t)b * 1024 + hd * 64) * T;
        a.s0 = rs0 * 64; a.n0 = rs3 + 8 - rs0; a.n1 = 4;
        a.rpb = p.na_rpb + ((size_t)li * 8 + hd) * 15 * 31;
        a.rq0 = r0; a.us = rs0;
        attn_item<64, 2>(a, smem);
      } else if (id < 2048 + 128) {
        const int g = id - 2048, b = g >> 3, hd = g & 7;
        a.qo = QO + (size_t)(NLAT + b * 256) * 1024 + hd * 64;
        a.k1 = Kb + ((size_t)b * 16 + hd) * T * 64;
        a.vt = VT + ((size_t)b * 1024 + hd * 64) * T;
        a.s0 = 0; a.n0 = 0; a.n1 = 4;
        attn_item<64, 0>(a, smem);
      } else {
        const int id2 = id - 2048 - 128;
        const int qb = id2 & 1, g = id2 >> 1, b = g >> 2, j = g & 3;
        a.qo = QO + (size_t)(NLAT + b * 256 + qb * 128) * 1024 + 512 + j * 128;
        a.k1 = Kb + ((size_t)b * 16 + 8 + 2 * j) * T * 64;
        a.k2 = Kb + ((size_t)b * 16 + 8 + 2 * j + 1) * T * 64;
        a.vt = VT + ((size_t)b * 1024 + 512 + j * 128) * T;
        a.s0 = 0; a.n0 = 0; a.n1 = 4;
        attn_item<128, 1>(a, smem);
      }
    }
  }
}

constexpr int N_PHASES = 30;
DI void run_phase(const Params& p, int ph, char* smem) {
  if (ph == 0) {
    phase0_mods(p, smem);
    phase0_weights(p, smem, 0);
    phase0_misc(p);
    return;
  }
  if (ph == 29) { phase_final(p); return; }
  const int l = (ph - 1) / 7, s = (ph - 1) % 7;
  switch (s) {
    case 0: phase_prep(p, l, 0); break;
    case 1: phase_qkv(p, l, smem); break;
    case 2: phase_attn(p, l, smem); break;
    case 3: phase_res(p, l, 0, smem); break;
    case 4: phase_prep(p, l, 1); break;
    case 5: phase_up(p, l, smem); break;
    default: phase_res(p, l, 1, smem); break;
  }
}

#if MK_MULTI
__global__ void __launch_bounds__(512, 2) fwd_megakernel(Params p, int ph_lo, int ph_hi) {
  __shared__ __attribute__((aligned(16))) char smem[SMEM_BYTES];
  for (int ph = ph_lo; ph < ph_hi; ++ph) run_phase(p, ph, smem);
}
#else
#if USE_XCD_BARRIER
#define GRID_BARRIER() xcd_barrier(xb)
#else
#define GRID_BARRIER() grid.sync()
#endif
__global__ void __launch_bounds__(512, 2) fwd_megakernel(Params p, int ph_lo, int ph_hi) {
  __shared__ __attribute__((aligned(16))) char smem[SMEM_BYTES];
  __shared__ __attribute__((aligned(16))) unsigned xb_words[4];
  cg::grid_group grid = cg::this_grid();
  if (threadIdx.x < 4) xb_words[threadIdx.x] = 0u;
  __syncthreads();
  const XcdBarrier xb = xcd_barrier_post((unsigned*)(p.ws + OFF_BAR), (volatile LAS unsigned*)xb_words);
  phase0_mods(p, smem);
  phase0_weights(p, smem, 0);
  phase0_misc(p);
  if (p.out == nullptr) grid.sync();
  GRID_BARRIER();
#pragma unroll 1
  for (int l = 0; l < 4; ++l) {
    phase_prep(p, l, 0);
    GRID_BARRIER();
#if PROBE == 1
    phase_qkv(p, l, smem);
    GRID_BARRIER();
    phase_attn(p, l, smem);
    GRID_BARRIER();
#endif
#if PROBE == 2
    phase_qkv(p, l, smem);
    GRID_BARRIER();
#endif
#if PROBE == 4
    phase_qkv_null(p, l, smem);
    GRID_BARRIER();
#endif
#if PROBE == 5
    GRID_BARRIER(); GRID_BARRIER(); GRID_BARRIER(); GRID_BARRIER(); GRID_BARRIER(); GRID_BARRIER(); GRID_BARRIER();
#endif
    phase_qkv(p, l, smem);
    GRID_BARRIER();
    if (l == 0 && (bid() & 1)) phase0_weights(p, smem, 1);
    phase_attn(p, l, smem);
    if (l == 0 && !(bid() & 1)) phase0_weights(p, smem, 1);
    GRID_BARRIER();
    phase_res(p, l, 0, smem);
    GRID_BARRIER();
    phase_prep(p, l, 1);
    GRID_BARRIER();
#if PROBE == 3
    phase_up(p, l, smem);
    GRID_BARRIER();
#endif
    phase_up(p, l, smem);
    GRID_BARRIER();
    phase_res(p, l, 1, smem);
    GRID_BARRIER();
  }
  phase_final(p);
}
#endif

extern "C" void kernel_launch(void* const* d_in, const int* in_sizes, int n_in, void* d_out, int out_size, void* d_ws, size_t ws_size,
                              hipStream_t stream) {
  static int grid_blocks = 0;
  if (!grid_blocks) {
    int dev = 0, cus = 0, per_cu = 0;
    hipGetDevice(&dev);
    hipDeviceGetAttribute(&cus, hipDeviceAttributeMultiprocessorCount, dev);
    hipOccupancyMaxActiveBlocksPerMultiprocessor(&per_cu, fwd_megakernel, NTHR, 0);
    per_cu = 1;
    grid_blocks = cus * per_cu;
  }
  if (ws_size < WS_NEEDED) fprintf(stderr, "workspace too small: %zu < %zu\n", ws_size, (size_t)WS_NEEDED);
  Params p{};
  p.x = (const float*)d_in[0]; p.c = (const float*)d_in[1]; p.ctx = (const float*)d_in[2]; p.c_ctx = (const float*)d_in[3];
  p.w_ada = (const float*)d_in[4]; p.b_ada = (const float*)d_in[5]; p.ln_g = (const float*)d_in[6]; p.ln_b = (const float*)d_in[7];
  p.w_in_ab = (const float*)d_in[8]; p.w_o_ab = (const float*)d_in[9]; p.na_rpb = (const float*)d_in[10];
  p.diff_lambda = (const float*)d_in[11]; p.diff_subln = (const float*)d_in[12]; p.w_in_c = (const float*)d_in[13];
  p.w_o_c = (const float*)d_in[14]; p.gqa_qk_norm = (const float*)d_in[15]; p.w_up = (const float*)d_in[16];
  p.conv_w = (const float*)d_in[17]; p.conv_b = (const float*)d_in[18]; p.w_down = (const float*)d_in[19];
  p.out = (float*)d_out;
  p.ws = (char*)d_ws;
  hipMemsetAsync((char*)d_ws + OFF_BAR, 0, 16384, stream);
#if MK_MULTI
  for (int ph = 0; ph < N_PHASES; ++ph) {
    hipLaunchKernelGGL(fwd_megakernel, dim3(grid_blocks), dim3(NTHR), 0, stream, p, ph, ph + 1);
  }
#else
  int lo = 0, hi = N_PHASES;
  void* args[] = {&p, &lo, &hi};
  hipError_t e = hipLaunchCooperativeKernel((void*)fwd_megakernel, dim3(grid_blocks), dim3(NTHR), args, 0, stream);
  if (e != hipSuccess) fprintf(stderr, "cooperative launch failed: %s (grid %d)\n", hipGetErrorString(e), grid_blocks);
#endif
}
```

```cpp
#include <hip/hip_runtime.h>
#include <hip/hip_cooperative_groups.h>
#include <cstdio>
namespace cg = cooperative_groups;

#ifndef PROBE
#define PROBE 0
#endif
#ifndef USE_XCD_BARRIER
#define USE_XCD_BARRIER 1
#endif
#ifndef MK_MULTI
#define MK_MULTI 0
#endif

#define DI __device__ __forceinline__
typedef unsigned short u16;
typedef __attribute__((ext_vector_type(8))) __bf16 bf8;
typedef __attribute__((ext_vector_type(2))) __bf16 bf2;
typedef __attribute__((ext_vector_type(2))) float f2;
typedef __attribute__((ext_vector_type(16))) float f32x16;
typedef __attribute__((ext_vector_type(4))) _Float16 h4;
typedef __attribute__((ext_vector_type(8))) _Float16 h8;
typedef __attribute__((ext_vector_type(4))) unsigned u32x4;
typedef __attribute__((ext_vector_type(2))) unsigned u32x2;
typedef __attribute__((ext_vector_type(4))) float f32x4n;
typedef __attribute__((ext_vector_type(2))) float f32x2n;

constexpr int NLAT = 32768, NCTX = 4096, NROWS = 36864, T = 2304, DFF = 2816;
constexpr float ALPHA = 1.681792830507429f;
constexpr float EPS = 1e-6f;
constexpr float LOG2E = 1.4426950408889634f;

constexpr size_t OFF_MODS = 0;
constexpr size_t OFF_ROPE = OFF_MODS + 1671168;
constexpr size_t OFF_LAM = OFF_ROPE + 8192;
constexpr size_t OFF_WIN_E = OFF_LAM + 256;
constexpr size_t OFF_WIN_O = OFF_WIN_E + 12582912;
constexpr size_t OFF_WO = OFF_WIN_O + 6291456;
constexpr size_t OFF_WUP = OFF_WO + 8388608;
constexpr size_t OFF_WD = OFF_WUP + 46137344;
constexpr size_t OFF_X = OFF_WD + 23068672;
constexpr size_t OFF_H = OFF_X + 75497472;
constexpr size_t OFF_QO = OFF_H + 75497472;
constexpr size_t OFF_K = OFF_QO + 75497472;
constexpr size_t OFF_VT = OFF_K + 75497472;
constexpr size_t OFF_END = OFF_VT + 75497472;
constexpr size_t OFF_ACT = OFF_QO;
constexpr size_t OFF_BAR = OFF_END;
constexpr size_t WS_NEEDED = OFF_BAR + 16384;

constexpr int SMEM_BYTES = 131072 + 4096;
constexpr int NTHR = 512, NWAVE = 8;

struct Params {
  const float *x, *c, *ctx, *c_ctx, *w_ada, *b_ada, *ln_g, *ln_b, *w_in_ab, *w_o_ab, *na_rpb, *diff_lambda, *diff_subln,
      *w_in_c, *w_o_c, *gqa_qk_norm, *w_up, *conv_w, *conv_b, *w_down;
  float* out;
  char* ws;
};

DI unsigned pack2(float a, float b) { f2 v = {a, b}; bf2 r = __builtin_convertvector(v, bf2); return __builtin_bit_cast(unsigned, r); }
DI u16 f2bf(float a) { __bf16 b = (__bf16)a; return __builtin_bit_cast(u16, b); }
DI int crow(int i, int h) { return (i & 3) + 8 * (i >> 2) + 4 * h; }
DI f32x16 mfma32(bf8 a, bf8 b, f32x16 c) { return __builtin_amdgcn_mfma_f32_32x32x16_bf16(a, b, c, 0, 0, 0); }
DI int tid() { int t; asm volatile("v_mov_b32 %0, %1" : "=v"(t) : "v"((int)threadIdx.x)); return t; }
DI int bid() { int b; asm volatile("s_mov_b32 %0, %1" : "=s"(b) : "s"((int)blockIdx.x)); return b; }
typedef __attribute__((address_space(3))) char lds_char;
DI void glds16(const void* gptr, unsigned lds_addr) {
  asm volatile("s_mov_b32 m0, %0\n\ts_nop 0\n\tglobal_load_lds_dwordx4 %1, off" ::"s"(lds_addr), "v"(gptr) : "memory");
}
DI float ex2(float x) { return __builtin_amdgcn_exp2f(x); }
DI float shx(float v, int lane, int mask) { return __int_as_float(__builtin_amdgcn_ds_bpermute((lane ^ mask) << 2, __float_as_int(v))); }
DI float shi(float v, int src) { return __int_as_float(__builtin_amdgcn_ds_bpermute(src << 2, __float_as_int(v))); }
DI float wave_sum(float v, int lane) {
#pragma unroll
  for (int o = 1; o < 64; o <<= 1) v += shx(v, lane, o);
  return v;
}

#define XB_TMO      128
#define XB_XCNT(j)  (256  + 64 * (j))
#define XB_XSUB(j)  (1280 + 64 * (j))
#define XB_XGEN(j)  (2304 + 64 * (j))
#define XB_TOP      3328
#define XB_TOPGEN   3392
#define XCD_BAR_WORDS 3456
#define XB_SPIN_CAP (1u << 18)
#define LAS __attribute__((address_space(3)))
DI unsigned xb_ld(unsigned* p) { return __hip_atomic_load(p, __ATOMIC_RELAXED, __HIP_MEMORY_SCOPE_AGENT); }
DI unsigned xb_add(unsigned* p, unsigned v) { return __hip_atomic_fetch_add(p, v, __ATOMIC_RELAXED, __HIP_MEMORY_SCOPE_AGENT); }
DI unsigned xb_xcc_id() { return (unsigned)__builtin_amdgcn_s_getreg((3 << 11) | 20) & 0xFu; }
#define XB_SPIN(cond, bar) do { unsigned _sp = 0; while (cond) { __builtin_amdgcn_s_sleep(1); \
    if ((++_sp & 255u) == 0u) { if (xb_ld(&(bar)[XB_TMO])) break; if (_sp > XB_SPIN_CAP) { atomicAdd(&(bar)[XB_TMO], 1u); break; } } } } while (0)
struct XcdBarrier { unsigned* bar; unsigned x; volatile LAS unsigned* st; };
DI XcdBarrier xcd_barrier_post(unsigned* bar, volatile LAS unsigned* st) {
  XcdBarrier b; b.bar = bar; b.x = xb_xcc_id(); b.st = st;
  if (threadIdx.x == 0) (void)xb_add(&bar[XB_XCNT(b.x)], 1u);
  return b;
}
DI void xcd_barrier_complete(unsigned* bar, unsigned x, unsigned& nloc, unsigned& nx) {
  const unsigned G = gridDim.x * gridDim.y * gridDim.z;
  unsigned sum, cnt, mine, sp = 0u;
  for (;;) {
    sum = 0u; cnt = 0u; mine = 0u;
#pragma unroll
    for (unsigned j = 0; j < 16; ++j) { const unsigned c = xb_ld(&bar[XB_XCNT(j)]); sum += c; cnt += (c > 0u) ? 1u : 0u; mine = (j == x) ? c : mine; }
    if (sum == G) break;
    __builtin_amdgcn_s_sleep(1);
    if ((++sp & 255u) == 0u) { if (xb_ld(&bar[XB_TMO])) break; if (sp > XB_SPIN_CAP) { atomicAdd(&bar[XB_TMO], 1u); break; } }
  }
  nloc = mine > 0u ? mine : 1u; nx = cnt > 0u ? cnt : 1u;
}
DI void xcd_barrier(const XcdBarrier& b) {
  asm volatile("s_waitcnt vmcnt(0)" ::: "memory");
  __syncthreads();
  if (threadIdx.x == 0) {
    unsigned* bar = b.bar;
    __builtin_amdgcn_s_waitcnt(0);
    unsigned nloc = b.st[0], nx = b.st[1];
    if (nloc == 0u) { xcd_barrier_complete(bar, b.x, nloc, nx); b.st[0] = nloc; b.st[1] = nx; }
    const unsigned old = xb_add(&bar[XB_XSUB(b.x)], 1u);
    const unsigned gen = old / nloc;
    if (old + 1u == (gen + 1u) * nloc) {
      __builtin_amdgcn_fence(__ATOMIC_RELEASE, "agent");
      asm volatile("s_waitcnt vmcnt(0)" ::: "memory");
      const unsigned og = xb_add(&bar[XB_TOP], 1u);
      const unsigned tg = og / nx;
      if (og + 1u == (tg + 1u) * nx) xb_add(&bar[XB_TOPGEN], 1u);
      else XB_SPIN(xb_ld(&bar[XB_TOPGEN]) == tg, bar);
      __builtin_amdgcn_fence(__ATOMIC_ACQUIRE, "agent");
      xb_add(&bar[XB_XGEN(b.x)], 1u);
      asm volatile("s_waitcnt vmcnt(0)" ::: "memory");
    } else {
      XB_SPIN(xb_ld(&bar[XB_XGEN(b.x)]) == gen, bar);
      __builtin_amdgcn_fence(__ATOMIC_ACQUIRE, "agent");
      asm volatile("s_waitcnt vmcnt(0)" ::: "memory");
    }
  }
  __syncthreads();
}

DI void phase0_mods(const Params& p, char* smem) {
  float* condS = (float*)smem;
  float* red = (float*)(smem + 17 * 512 * 4);
  float* mods = (float*)(p.ws + OFF_MODS);
  const int t = tid(), lane = t & 63, w = __builtin_amdgcn_readfirstlane(t >> 6);
  const int cq = t & 15, kg = t >> 4;
  for (int item = bid(); item < 4 * 96; item += gridDim.x) {
    const int l = item / 96, cb = item % 96;
    const int col = cb * 64 + cq * 4;
    float acc[17][4];
#pragma unroll
    for (int i = 0; i < 17; ++i) { acc[i][0] = 0.f; acc[i][1] = 0.f; acc[i][2] = 0.f; acc[i][3] = 0.f; }
    for (int kh = 0; kh < 2; ++kh) {
      __syncthreads();
      for (int e = t; e < 17 * 512; e += NTHR) {
        const int i = e >> 9, k = (e & 511) + kh * 512;
        const float v = (i < 16) ? p.c[i * 1024 + k] : p.c_ctx[k];
        condS[e] = v / (1.f + __expf(-v));
      }
      __syncthreads();
      const float* wp = p.w_ada + ((size_t)l * 1024 + kh * 512 + kg * 16) * 6144 + col;
#pragma unroll 2
      for (int kk = 0; kk < 16; ++kk) {
        const f32x4n wv = *(const f32x4n*)(wp + (size_t)kk * 6144);
#pragma unroll
        for (int i = 0; i < 17; ++i) {
          const float cv = condS[i * 512 + kg * 16 + kk];
          acc[i][0] += cv * wv.x; acc[i][1] += cv * wv.y; acc[i][2] += cv * wv.z; acc[i][3] += cv * wv.w;
        }
      }
    }
#pragma unroll
    for (int i = 0; i < 17; ++i)
#pragma unroll
      for (int j = 0; j < 4; ++j) {
        float v = acc[i][j];
        v += shx(v, lane, 16);
        v += shx(v, lane, 32);
        acc[i][j] = v;
      }
    __syncthreads();
    if (lane < 16) {
#pragma unroll
      for (int i = 0; i < 17; ++i)
#pragma unroll
        for (int j = 0; j < 4; ++j) red[(w * 17 + i) * 64 + cq * 4 + j] = acc[i][j];
    }
    __syncthreads();
    for (int e = t; e < 17 * 64; e += NTHR) {
      const int i = e >> 6, cc = e & 63;
      float s = 0.f;
#pragma unroll
      for (int ww = 0; ww < NWAVE; ++ww) s += red[(ww * 17 + i) * 64 + cc];
      mods[(size_t)(l * 17 + i) * 6144 + cb * 64 + cc] = s + p.b_ada[l * 6144 + cb * 64 + cc];
    }
  }
}

DI void transpose_tile(const float* __restrict__ src, int ldsrc, int k0, int c0, int c1, u16* __restrict__ dst, int lddst, int p0, float* tileS) {
  const int t = tid();
  __syncthreads();
  {
    const int n = t & 63;
    const int col = (n < 32) ? (c0 + n) : (c1 + n - 32);
#pragma unroll
    for (int j = 0; j < 8; ++j) {
      const int kk = (t >> 6) + 8 * j;
      tileS[kk * 65 + n] = src[(size_t)(k0 + kk) * ldsrc + col];
    }
  }
  __syncthreads();
  {
    const int kk2 = (t & 7) * 8;
    const int n2 = t >> 3;
    u32x4 o;
    o.x = pack2(tileS[(kk2 + 0) * 65 + n2], tileS[(kk2 + 1) * 65 + n2]);
    o.y = pack2(tileS[(kk2 + 2) * 65 + n2], tileS[(kk2 + 3) * 65 + n2]);
    o.z = pack2(tileS[(kk2 + 4) * 65 + n2], tileS[(kk2 + 5) * 65 + n2]);
    o.w = pack2(tileS[(kk2 + 6) * 65 + n2], tileS[(kk2 + 7) * 65 + n2]);
    *(u32x4*)(dst + (size_t)(p0 + n2) * lddst + k0 + kk2) = o;
  }
}

DI void phase0_weights(const Params& p, char* smem, int sel) {
  float* tileS = (float*)smem;
  for (int item = bid(); item < 11776; item += gridDim.x) {
    int it = item;
    if (it < 1536) {
      const int i = it / 768, r = it % 768, kt = r / 48, nt = r % 48;
      if ((i == 0) != (sel == 0)) continue;
      transpose_tile(p.w_in_ab + (size_t)i * 1024 * 3072, 3072, kt * 64, nt * 64, nt * 64 + 32,
                     (u16*)(p.ws + OFF_WIN_E) + (size_t)i * 3072 * 1024, 1024, nt * 64, tileS);
      continue;
    }
    it -= 1536;
    if (it < 768) {
      const int i = it / 384, r = it % 384, kt = r / 24, nt = r % 24;
      if (sel == 0) continue;
      transpose_tile(p.w_in_c + (size_t)i * 1024 * 1536, 1536, kt * 64, nt * 64, nt * 64 + 32,
                     (u16*)(p.ws + OFF_WIN_O) + (size_t)i * 1536 * 1024, 1024, nt * 64, tileS);
      continue;
    }
    it -= 768;
    if (it < 1024) {
      const int l = it / 256, r = it % 256, kt = r / 16, nt = r % 16;
      if (sel == 0) continue;
      const float* src = ((l & 1) ? p.w_o_c : p.w_o_ab) + (size_t)(l >> 1) * 1024 * 1024;
      transpose_tile(src, 1024, kt * 64, nt * 64, nt * 64 + 32, (u16*)(p.ws + OFF_WO) + (size_t)l * 1024 * 1024, 1024, nt * 64, tileS);
      continue;
    }
    it -= 1024;
    if (it < 5632) {
      const int l = it / 1408, r = it % 1408, kt = r / 88, pt = r % 88;
      if (sel == 0) continue;
      const int ntile = pt >> 2, wn = pt & 3;
      const int c0 = ntile * 128 + wn * 32;
      transpose_tile(p.w_up + (size_t)l * 1024 * 5632, 5632, kt * 64, c0, c0 + 2816,
                     (u16*)(p.ws + OFF_WUP) + (size_t)l * 5632 * 1024, 1024, pt * 64, tileS);
      continue;
    }
    it -= 5632;
    {
      const int l = it / 704, r = it % 704, kt = r / 16, nt = r % 16;
      if (sel == 0) continue;
      transpose_tile(p.w_down + (size_t)l * 2816 * 1024, 1024, kt * 64, nt * 64, nt * 64 + 32,
                     (u16*)(p.ws + OFF_WD) + (size_t)l * 1024 * 2816, 2816, nt * 64, tileS);
    }
  }
}

DI void phase0_misc(const Params& p) {
  if (bid() != 0) return;
  const int t = tid();
  f32x2n* rope = (f32x2n*)(p.ws + OFF_ROPE);
  for (int e = t; e < 1024; e += NTHR) {
    const int pos = e >> 4, f = e & 15;
    const float inv = ex2(-(float)f * 0.8304820237218406f);
    const float ang = (float)pos * inv;
    rope[e] = f32x2n{__cosf(ang), __sinf(ang)};
  }
  if (t < 2) {
    const float* lv = p.diff_lambda + t * 256;
    float s1 = 0.f, s2 = 0.f;
    for (int k = 0; k < 64; ++k) { s1 += lv[k] * lv[64 + k]; s2 += lv[128 + k] * lv[192 + k]; }
    const float li = (t == 0) ? 0.2f : 0.47071301834358393f;
    ((float*)(p.ws + OFF_LAM))[t] = __expf(s1) - __expf(s2) + li;
  }
}

DI void phase_prep(const Params& p, int l, int which) {
  const int t = tid(), lane = t & 63, w = __builtin_amdgcn_readfirstlane(t >> 6);
  const int rows = (which == 1 && l == 3) ? NLAT : NROWS;
  const bool raw = (which == 0 && l == 0);
  const float* mods = (const float*)(p.ws + OFF_MODS);
  const float* g = raw ? nullptr : (which == 0 ? p.ln_g + ((l - 1) * 2 + 1) * 1024 : p.ln_g + (l * 2) * 1024);
  const float* bb = raw ? nullptr : (which == 0 ? p.ln_b + ((l - 1) * 2 + 1) * 1024 : p.ln_b + (l * 2) * 1024);
  _Float16* X = (_Float16*)(p.ws + OFF_X);
  u16* H = (u16*)(p.ws + OFF_H);
  constexpr int NR = 2;
  const int nwv = gridDim.x * NWAVE;
  for (int Rb = bid() * NWAVE + w; Rb < rows; Rb += nwv * NR) {
    float v[NR][16];
    int RR[NR];
#pragma unroll
    for (int u = 0; u < NR; ++u) {
      const int R0 = Rb + u * nwv;
      RR[u] = R0 < rows ? R0 : Rb;
    }
    if (raw) {
#pragma unroll
      for (int u = 0; u < NR; ++u) {
        const int R = RR[u];
        const float* src = (R < NLAT) ? p.x + (size_t)R * 1024 : p.ctx + (size_t)(R - NLAT) * 1024;
#pragma unroll
        for (int q = 0; q < 2; ++q) {
          const f32x4n a = *(const f32x4n*)(src + q * 512 + lane * 8);
          const f32x4n b = *(const f32x4n*)(src + q * 512 + lane * 8 + 4);
          v[u][q * 8 + 0] = a.x; v[u][q * 8 + 1] = a.y; v[u][q * 8 + 2] = a.z; v[u][q * 8 + 3] = a.w;
          v[u][q * 8 + 4] = b.x; v[u][q * 8 + 5] = b.y; v[u][q * 8 + 6] = b.z; v[u][q * 8 + 7] = b.w;
        }
      }
    } else {
#pragma unroll
      for (int u = 0; u < NR; ++u)
#pragma unroll
        for (int q = 0; q < 2; ++q) {
          const h8 a = *(const h8*)(X + (size_t)RR[u] * 1024 + q * 512 + lane * 8);
#pragma unroll
          for (int j = 0; j < 8; ++j) v[u][q * 8 + j] = (float)a[j];
        }
      float s[NR], mean[NR], s2[NR], rstd[NR];
#pragma unroll
      for (int u = 0; u < NR; ++u) {
        s[u] = 0.f;
#pragma unroll
        for (int j = 0; j < 16; ++j) s[u] += v[u][j];
      }
#pragma unroll
      for (int o = 1; o < 64; o <<= 1)
#pragma unroll
        for (int u = 0; u < NR; ++u) s[u] += shx(s[u], lane, o);
#pragma unroll
      for (int u = 0; u < NR; ++u) {
        mean[u] = s[u] * (1.f / 1024.f);
        s2[u] = 0.f;
#pragma unroll
        for (int j = 0; j < 16; ++j) { const float d = v[u][j] - mean[u]; s2[u] += d * d; }
      }
#pragma unroll
      for (int o = 1; o < 64; o <<= 1)
#pragma unroll
        for (int u = 0; u < NR; ++u) s2[u] += shx(s2[u], lane, o);
#pragma unroll
      for (int u = 0; u < NR; ++u) rstd[u] = rsqrtf(s2[u] * (1.f / 1024.f) + EPS);
#pragma unroll
      for (int q = 0; q < 2; ++q) {
        const int c = q * 512 + lane * 8;
        const f32x4n g0 = *(const f32x4n*)(g + c), g1 = *(const f32x4n*)(g + c + 4);
        const f32x4n b0 = *(const f32x4n*)(bb + c), b1 = *(const f32x4n*)(bb + c + 4);
        const float gg[8] = {g0.x, g0.y, g0.z, g0.w, g1.x, g1.y, g1.z, g1.w};
        const float bv[8] = {b0.x, b0.y, b0.z, b0.w, b1.x, b1.y, b1.z, b1.w};
#pragma unroll
        for (int u = 0; u < NR; ++u)
#pragma unroll
          for (int j = 0; j < 8; ++j) v[u][q * 8 + j] = (v[u][q * 8 + j] - mean[u]) * rstd[u] * gg[j] + bv[j];
      }
    }
#pragma unroll
    for (int u = 0; u < NR; ++u) {
      const int R = RR[u];
      const int mi = (R < NLAT) ? (R >> 11) : 16;
      const float* md = mods + (size_t)(l * 17 + mi) * 6144 + (which == 0 ? 0 : 3 * 1024);
#pragma unroll
      for (int q = 0; q < 2; ++q) {
        const int c = q * 512 + lane * 8;
        h8 xo;
#pragma unroll
        for (int j = 0; j < 8; ++j) xo[j] = (_Float16)v[u][q * 8 + j];
        *(h8*)(X + (size_t)R * 1024 + c) = xo;
        const f32x4n s0 = *(const f32x4n*)(md + c), s1 = *(const f32x4n*)(md + c + 4);
        const f32x4n c0 = *(const f32x4n*)(md + 1024 + c), c1 = *(const f32x4n*)(md + 1024 + c + 4);
        const float sh[8] = {s0.x, s0.y, s0.z, s0.w, s1.x, s1.y, s1.z, s1.w};
        const float sc[8] = {c0.x, c0.y, c0.z, c0.w, c1.x, c1.y, c1.z, c1.w};
        float hv[8];
#pragma unroll
        for (int j = 0; j < 8; ++j) hv[j] = v[u][q * 8 + j] * (1.f + sc[j]) + sh[j];
        u32x4 o;
        o.x = pack2(hv[0], hv[1]); o.y = pack2(hv[2], hv[3]); o.z = pack2(hv[4], hv[5]); o.w = pack2(hv[6], hv[7]);
        *(u32x4*)(H + (size_t)R * 1024 + c) = o;
      }
    }
  }
}

DI void phase_final(const Params& p) {
  const int t = tid(), lane = t & 63, w = __builtin_amdgcn_readfirstlane(t >> 6);
  const float* g = p.ln_g + (3 * 2 + 1) * 1024;
  const float* bb = p.ln_b + (3 * 2 + 1) * 1024;
  const _Float16* X = (const _Float16*)(p.ws + OFF_X);
  constexpr int NR = 2;
  const int nwv = gridDim.x * NWAVE;
  for (int Rb = bid() * NWAVE + w; Rb < NLAT; Rb += nwv * NR) {
    float v[NR][16];
    int RR[NR];
#pragma unroll
    for (int u = 0; u < NR; ++u) { const int R0 = Rb + u * nwv; RR[u] = R0 < NLAT ? R0 : Rb; }
#pragma unroll
    for (int u = 0; u < NR; ++u)
#pragma unroll
      for (int q = 0; q < 2; ++q) {
        const h8 a = *(const h8*)(X + (size_t)RR[u] * 1024 + q * 512 + lane * 8);
#pragma unroll
        for (int j = 0; j < 8; ++j) v[u][q * 8 + j] = (float)a[j];
      }
    float s[NR], mean[NR], s2[NR], rstd[NR];
#pragma unroll
    for (int u = 0; u < NR; ++u) {
      s[u] = 0.f;
#pragma unroll
      for (int j = 0; j < 16; ++j) s[u] += v[u][j];
    }
#pragma unroll
    for (int o = 1; o < 64; o <<= 1)
#pragma unroll
      for (int u = 0; u < NR; ++u) s[u] += shx(s[u], lane, o);
#pragma unroll
    for (int u = 0; u < NR; ++u) {
      mean[u] = s[u] * (1.f / 1024.f);
      s2[u] = 0.f;
#pragma unroll
      for (int j = 0; j < 16; ++j) { const float d = v[u][j] - mean[u]; s2[u] += d * d; }
    }
#pragma unroll
    for (int o = 1; o < 64; o <<= 1)
#pragma unroll
      for (int u = 0; u < NR; ++u) s2[u] += shx(s2[u], lane, o);
#pragma unroll
    for (int u = 0; u < NR; ++u) rstd[u] = rsqrtf(s2[u] * (1.f / 1024.f) + EPS);
#pragma unroll
    for (int q = 0; q < 2; ++q) {
      const int c = q * 512 + lane * 8;
      const f32x4n g0 = *(const f32x4n*)(g + c), g1 = *(const f32x4n*)(g + c + 4);
      const f32x4n b0 = *(const f32x4n*)(bb + c), b1 = *(const f32x4n*)(bb + c + 4);
#pragma unroll
      for (int u = 0; u < NR; ++u) {
        f32x4n o0, o1;
        o0.x = (v[u][q * 8 + 0] - mean[u]) * rstd[u] * g0.x + b0.x; o0.y = (v[u][q * 8 + 1] - mean[u]) * rstd[u] * g0.y + b0.y;
        o0.z = (v[u][q * 8 + 2] - mean[u]) * rstd[u] * g0.z + b0.z; o0.w = (v[u][q * 8 + 3] - mean[u]) * rstd[u] * g0.w + b0.w;
        o1.x = (v[u][q * 8 + 4] - mean[u]) * rstd[u] * g1.x + b1.x; o1.y = (v[u][q * 8 + 5] - mean[u]) * rstd[u] * g1.y + b1.y;
        o1.z = (v[u][q * 8 + 6] - mean[u]) * rstd[u] * g1.z + b1.z; o1.w = (v[u][q * 8 + 7] - mean[u]) * rstd[u] * g1.w + b1.w;
        *(f32x4n*)(p.out + (size_t)RR[u] * 1024 + c) = o0;
        *(f32x4n*)(p.out + (size_t)RR[u] * 1024 + c + 4) = o1;
      }
    }
  }
}

template <int MB, class Epi>
DI void gemm_tile(const u16* __restrict__ A, int lda, int row0, int Mrows, const u16* __restrict__ Bt, int ldb, int K, char* smem, Epi& epi, int rot) {
  char* As = smem;
  char* Bs = smem + 65536;
  const unsigned lds_base = (unsigned)(size_t)(lds_char*)smem;
  const int t = tid(), lane = t & 63, w = __builtin_amdgcn_readfirstlane(t >> 6), wm = w >> 2, wn = w & 3, r = lane & 31, h = lane >> 5;
  constexpr int NAJ = MB;
  const int lr = t >> 3;
  const int lch = (t & 7) ^ ((lr >> 1) & 7);
  unsigned aoff[NAJ];
#pragma unroll
  for (int j = 0; j < NAJ; ++j) {
    int gr = row0 + lr + 64 * j;
    gr = gr < 0 ? 0 : (gr > Mrows - 1 ? Mrows - 1 : gr);
    aoff[j] = (unsigned)gr * (unsigned)lda + lch * 8;
  }
  const u16* bp = Bt + (size_t)lr * ldb + lch * 8;
  f32x16 acc[2][MB];
#pragma unroll
  for (int nb = 0; nb < 2; ++nb)
#pragma unroll
    for (int mb = 0; mb < MB; ++mb)
#pragma unroll
      for (int i = 0; i < 16; ++i) acc[nb][mb][i] = 0.f;
  const int KT = K >> 6;
  int kcur = rot % KT;
#define GEMM_PIECE(STG, PC)                                                                                           \
  {                                                                                                                   \
    if ((PC) < NAJ)                                                                                                   \
      glds16(A + ko_ + aoff[(PC) < NAJ ? (PC) : 0], lds_base + (STG) * 32768 + (w * 64 + 512 * (PC)) * 16);           \
    else if ((PC) < NAJ + 4)                                                                                          \
      glds16(bp + ko_ + (size_t)(64 * ((PC) - NAJ)) * ldb,                                                            \
             lds_base + 65536 + (STG) * 32768 + (w * 64 + 512 * ((PC) - NAJ)) * 16);                                  \
  }
#define GEMM_STAGE(STG)                                                                                               \
  {                                                                                                                   \
    const int ko_ = kcur * 64;                                                                                        \
    _Pragma("unroll") for (int pc = 0; pc < NAJ + 4; ++pc) GEMM_PIECE(STG, pc)                                        \
  }
  GEMM_STAGE(0)
  asm volatile("s_waitcnt vmcnt(0)" ::: "memory");
  __syncthreads();
  const int sw = (r >> 1) & 7;
  int foff[4];
#pragma unroll
  for (int ks = 0; ks < 4; ++ks) foff[ks] = r * 128 + (((2 * ks + h) ^ sw) << 4);
  bf8 af[2][MB], bfr[2][2];
  {
    const char* as0 = As + wm * (32 * MB) * 128;
    const char* bs0 = Bs + wn * 64 * 128;
#pragma unroll
    for (int mb = 0; mb < MB; ++mb) af[0][mb] = *(const bf8*)(as0 + mb * 32 * 128 + foff[0]);
#pragma unroll
    for (int nb = 0; nb < 2; ++nb) bfr[0][nb] = *(const bf8*)(bs0 + nb * 32 * 128 + foff[0]);
  }
  const int kbase = rot % KT;
  if (KT > 1) {
    const int k1_ = (kbase + 1 >= KT) ? kbase + 1 - KT : kbase + 1;
    const int ko_ = k1_ * 64;
#pragma unroll
    for (int pc = 0; pc < 3; ++pc) GEMM_PIECE(1, pc)
  }
  for (int kt = 0; kt < KT; ++kt) {
    const bool more = (kt + 1 < KT);
    const bool more2 = (kt + 2 < KT);
    const int nstg = (kt + 1) & 1;
    const char* as = As + (kt & 1) * 32768 + wm * (32 * MB) * 128;
    const char* bs = Bs + (kt & 1) * 32768 + wn * 64 * 128;
    int k1_ = kbase + kt + 1; if (k1_ >= KT) k1_ -= KT;
    int k2_ = kbase + kt + 2; if (k2_ >= KT) k2_ -= KT; if (k2_ >= KT) k2_ -= KT;
#pragma unroll
    for (int ks = 0; ks < 3; ++ks) {
#pragma unroll
      for (int idx = 0; idx < 2 * MB; ++idx) {
        const int nb = idx / MB, mb = idx % MB;
        acc[nb][mb] = mfma32(bfr[ks & 1][nb], af[ks & 1][mb], acc[nb][mb]);
        if (idx < MB) af[(ks + 1) & 1][idx] = *(const bf8*)(as + idx * 32 * 128 + foff[ks + 1]);
        else if (idx < MB + 2) bfr[(ks + 1) & 1][idx - MB] = *(const bf8*)(bs + (idx - MB) * 32 * 128 + foff[ks + 1]);
        if (more && ks < 2 && idx < 3) {
          const int ko_ = k1_ * 64;
          GEMM_PIECE(nstg, 3 + ks * 3 + idx)
        }
        __builtin_amdgcn_sched_barrier(0);
      }
    }
    if (more) {
      asm volatile("s_waitcnt vmcnt(0)" ::: "memory");
      __syncthreads();
      if (more2) {
        const int ko_ = k2_ * 64;
#pragma unroll
        for (int pc = 0; pc < 3; ++pc) GEMM_PIECE(kt & 1, pc)
      }
      __builtin_amdgcn_sched_barrier(0);
      const char* asn = As + nstg * 32768 + wm * (32 * MB) * 128;
      const char* bsn = Bs + nstg * 32768 + wn * 64 * 128;
#pragma unroll
      for (int mb = 0; mb < MB; ++mb) af[0][mb] = *(const bf8*)(asn + mb * 32 * 128 + foff[0]);
#pragma unroll
      for (int nb = 0; nb < 2; ++nb) bfr[0][nb] = *(const bf8*)(bsn + nb * 32 * 128 + foff[0]);
    }
#pragma unroll
    for (int nb = 0; nb < 2; ++nb)
#pragma unroll
      for (int mb = 0; mb < MB; ++mb) acc[nb][mb] = mfma32(bfr[1][nb], af[1][mb], acc[nb][mb]);
#pragma unroll
    for (int gk = 0; gk < 2 * MB; ++gk) {
      __builtin_amdgcn_sched_group_barrier(0x008, 1, 0);
      __builtin_amdgcn_sched_group_barrier(0x100, 1, 0);
    }
    __builtin_amdgcn_sched_barrier(0);
  }
  __syncthreads();
  epi(acc, wm, wn, r, h);
}

template <int MB>
struct EpiRes {
  _Float16* X; const float* gate; int row0, n0; u16* ostage;
  DI void operator()(f32x16 (&acc)[2][MB], int wm, int wn, int r, int h) {
    u16* slab = ostage + (wm * 4 + wn) * (64 * 72);
    const int lane = h * 32 + r;
#pragma unroll
    for (int mb = 0; mb < MB; ++mb) {
      const int tokl = (mb & 1) * 32 + r;
#pragma unroll
      for (int nb = 0; nb < 2; ++nb)
#pragma unroll
        for (int ig = 0; ig < 4; ++ig) {
          u32x2 o;
          o.x = pack2(acc[nb][mb][ig * 4 + 0], acc[nb][mb][ig * 4 + 1]);
          o.y = pack2(acc[nb][mb][ig * 4 + 2], acc[nb][mb][ig * 4 + 3]);
          *(u32x2*)(slab + tokl * 72 + nb * 32 + ig * 8 + h * 4) = o;
        }
      if ((mb & 1) || mb == MB - 1) {
        asm volatile("s_waitcnt lgkmcnt(0)" ::: "memory");
        const int ntok = (mb & 1) ? 64 : 32;
        const int R0 = row0 + wm * (32 * MB) + (mb >> 1) * 64;
#pragma unroll
        for (int j = 0; j < 8; ++j) {
          const int rowl = (lane >> 3) + 8 * j, ch = lane & 7;
          if (rowl < ntok) {
            const u32x4 yv = *(const u32x4*)(slab + rowl * 72 + ch * 8);
            const int R = R0 + rowl;
            const int mi = (R < NLAT) ? (R >> 11) : 16;
            const int col = n0 + wn * 64 + ch * 8;
            const float* g = gate + (size_t)mi * 6144 + col;
            const f32x4n g0 = *(const f32x4n*)(g), g1 = *(const f32x4n*)(g + 4);
            _Float16* xp = X + (size_t)R * 1024 + col;
            const h8 xv = *(const h8*)xp;
            const float y[8] = {__uint_as_float(yv.x << 16), __uint_as_float(yv.x & 0xffff0000u), __uint_as_float(yv.y << 16), __uint_as_float(yv.y & 0xffff0000u),
                                __uint_as_float(yv.z << 16), __uint_as_float(yv.z & 0xffff0000u), __uint_as_float(yv.w << 16), __uint_as_float(yv.w & 0xffff0000u)};
            const float gg[8] = {g0.x, g0.y, g0.z, g0.w, g1.x, g1.y, g1.z, g1.w};
            h8 o;
#pragma unroll
            for (int q = 0; q < 8; ++q) o[q] = (_Float16)(ALPHA * (float)xv[q] + gg[q] * y[q]);
            *(h8*)xp = o;
          }
        }
      }
    }
    __syncthreads();
  }
};

struct EpiQKV {
  int odd, row0, ntile;
  u16 *QO, *Kb, *VT;
  const f32x2n* rope;
  const float* qkn;
  u16* ostage;
  DI void operator()(f32x16 (&acc)[2][4], int wm, int wn, int r, int h) {
    const int cgi = ntile * 4 + wn;
    u16* slab = ostage + (wm * 4 + wn) * (64 * 72);
    int kind, dst, do_rope, do_norm;
    if (!odd) {
      const int seg = cgi >> 3, idx = cgi & 7;
      kind = seg % 3;
      do_rope = (seg == 3 || seg == 4);
      do_norm = 0;
      if (seg == 0) dst = idx * 64;
      else if (seg == 1) dst = idx;
      else if (seg == 2) dst = idx * 64;
      else if (seg == 3) dst = 512 + idx * 64;
      else if (seg == 4) dst = 8 + idx;
      else dst = 512 + idx * 64;
    } else {
      if (cgi < 16) { kind = 0; dst = cgi * 64; do_rope = 1; do_norm = 1; }
      else if (cgi < 20) { kind = 1; dst = cgi - 16; do_rope = 1; do_norm = 1; }
      else { kind = 2; dst = (cgi - 20) * 64; do_rope = 0; do_norm = 0; }
    }
    const int nkh = odd ? 4 : 16, nvr = odd ? 256 : 1024;
    const float* gn = qkn + (kind == 1 ? 64 : 0);
#pragma unroll
    for (int mb = 0; mb < 4; ++mb) {
      const int R = row0 + wm * 128 + mb * 32 + r;
      const bool lat = R < NLAT;
      const int b = lat ? (R >> 11) : ((R - NLAT) >> 8);
      const int tu = lat ? (R & 2047) : 2048 + ((R - NLAT) & 255);
      float v[2][16];
#pragma unroll
      for (int nb = 0; nb < 2; ++nb)
#pragma unroll
        for (int i = 0; i < 16; ++i) v[nb][i] = acc[nb][mb][i];
      if (do_norm) {
        float ss = 0.f;
#pragma unroll
        for (int nb = 0; nb < 2; ++nb)
#pragma unroll
          for (int i = 0; i < 16; ++i) ss += v[nb][i] * v[nb][i];
        ss += shx(ss, (h * 32 + r), 32);
        const float rs = rsqrtf(ss * (1.f / 64.f) + EPS);
#pragma unroll
        for (int nb = 0; nb < 2; ++nb)
#pragma unroll
          for (int ig = 0; ig < 4; ++ig) {
            const f32x4n gv = *(const f32x4n*)(gn + nb * 32 + ig * 8 + h * 4);
            v[nb][ig * 4 + 0] *= rs * gv.x; v[nb][ig * 4 + 1] *= rs * gv.y;
            v[nb][ig * 4 + 2] *= rs * gv.z; v[nb][ig * 4 + 3] *= rs * gv.w;
          }
      }
      if (do_rope && lat) {
#pragma unroll
        for (int nb = 0; nb < 2; ++nb) {
          const int pos = (nb == 0) ? (tu >> 6) : (tu & 63);
#pragma unroll
          for (int i = 0; i < 8; ++i) {
            const f32x2n cs = rope[pos * 16 + crow(i, h)];
            const float x1 = v[nb][i], x2 = v[nb][i + 8];
            v[nb][i] = x1 * cs.x - x2 * cs.y;
            v[nb][i + 8] = x2 * cs.x + x1 * cs.y;
          }
        }
      }
      const int tokl = (mb & 1) * 32 + r;
      if (kind == 2) {
#pragma unroll
        for (int nb = 0; nb < 2; ++nb)
#pragma unroll
          for (int i = 0; i < 16; ++i) slab[(nb * 32 + crow(i, h)) * 72 + tokl] = f2bf(v[nb][i]);
      } else {
#pragma unroll
        for (int nb = 0; nb < 2; ++nb)
#pragma unroll
          for (int ig = 0; ig < 4; ++ig) {
            u32x2 o;
            o.x = pack2(v[nb][ig * 4 + 0], v[nb][ig * 4 + 1]);
            o.y = pack2(v[nb][ig * 4 + 2], v[nb][ig * 4 + 3]);
            *(u32x2*)(slab + tokl * 72 + nb * 32 + ig * 8 + h * 4) = o;
          }
      }
      if (mb & 1) {
        asm volatile("s_waitcnt lgkmcnt(0)" ::: "memory");
        const int lane = h * 32 + r;
        const int R0 = row0 + wm * 128 + (mb >> 1) * 64;
        const bool lat0 = R0 < NLAT;
        const int b0 = lat0 ? (R0 >> 11) : ((R0 - NLAT) >> 8);
        const int tu0 = lat0 ? (R0 & 2047) : 2048 + ((R0 - NLAT) & 255);
#pragma unroll
        for (int j = 0; j < 8; ++j) {
          const int rowl = (lane >> 3) + 8 * j, ch = lane & 7;
          const u32x4 val = *(const u32x4*)(slab + rowl * 72 + ch * 8);
          u16* dp;
          if (kind == 2) dp = VT + ((size_t)b0 * nvr + dst + rowl) * T + tu0 + ch * 8;
          else if (kind == 0) dp = QO + (size_t)(R0 + rowl) * 1024 + dst + ch * 8;
          else dp = Kb + (((size_t)b0 * nkh + dst) * T + tu0 + rowl) * 64 + ch * 8;
          *(u32x4*)dp = val;
        }
      }
    }
    __syncthreads();
  }
};

DI float gelu_tanh(float g) {
  const float u = g * g;
  const float t = g * (-2.302208198f - 0.1029432397f * u);
  const float e = ex2(t);
  return g * __builtin_amdgcn_rcpf(1.f + e);
}

struct EpiUp {
  u16* act; const float* cw; const float* cb; int row0, Mrows, nt; float* edge; u16* ostage;
  DI void operator()(f32x16 (&acc)[2][4], int wm, int wn, int r, int h) {
    float* eb = edge + ((wm * 4 + wn) * 2) * 64;
    if (r == 0) {
#pragma unroll
      for (int nb = 0; nb < 2; ++nb)
#pragma unroll
        for (int i = 0; i < 16; ++i) eb[nb * 32 + crow(i, h)] = acc[nb][0][i];
    }
    if (r == 31) {
#pragma unroll
      for (int nb = 0; nb < 2; ++nb)
#pragma unroll
        for (int i = 0; i < 16; ++i) eb[64 + nb * 32 + crow(i, h)] = acc[nb][3][i];
    }
    __syncthreads();
    const float* ob = edge + (((wm ^ 1) * 4 + wn) * 2) * 64 + (wm == 0 ? 0 : 64);
    const int sp = (h << 5) | ((r - 1) & 31), sn = (h << 5) | ((r + 1) & 31);
    const int Rb = row0 + wm * 128 + r;
    u16* ost = ostage + (wm * 4 + wn) * (128 * 40);
    float pm[4], nm[4];
#pragma unroll
    for (int mb = 0; mb < 4; ++mb) {
      const int R = Rb + mb * 32;
      const bool lat = R < NLAT;
      const int tt = lat ? (R & 2047) : ((R - NLAT) & 255);
      pm[mb] = (tt == 0) ? 0.f : 1.f;
      nm[mb] = (tt == (lat ? 2047 : 255)) ? 0.f : 1.f;
    }
#pragma unroll
    for (int ig = 0; ig < 4; ++ig)
#pragma unroll
      for (int qp = 0; qp < 2; ++qp) {
        const int i0 = ig * 4 + qp * 2;
        float u[2][4][2];
#pragma unroll
        for (int nb = 0; nb < 2; ++nb) {
          int xp[4];
#pragma unroll
          for (int mb = 0; mb < 4; ++mb) xp[mb] = (int)pack2(acc[nb][mb][i0], acc[nb][mb][i0 + 1]);
          const float eo0 = ob[nb * 32 + crow(i0, h)], eo1 = ob[nb * 32 + crow(i0 + 1, h)];
          float w0[2], w1[2], w2[2], bz[2];
          {
            const int ff = nt * 128 + wn * 32 + crow(i0, h) + nb * DFF;
            const f32x2n a0 = *(const f32x2n*)(cw + ff), a1 = *(const f32x2n*)(cw + 2 * DFF + ff), a2 = *(const f32x2n*)(cw + 4 * DFF + ff),
                         a3 = *(const f32x2n*)(cb + ff);
            w0[0] = a0.x; w0[1] = a0.y; w1[0] = a1.x; w1[1] = a1.y; w2[0] = a2.x; w2[1] = a2.y; bz[0] = a3.x; bz[1] = a3.y;
          }
          int spm = 0;
#pragma unroll
          for (int mb = 0; mb < 4; ++mb) {
            const int spc = __builtin_amdgcn_ds_bpermute(sp << 2, xp[mb]);
            const int snc = __builtin_amdgcn_ds_bpermute(sn << 2, xp[mb]);
            const int snn = (mb < 3) ? __builtin_amdgcn_ds_bpermute(sn << 2, xp[mb < 3 ? mb + 1 : 3]) : 0;
            const int pv = (mb > 0) ? ((r == 0) ? spm : spc) : spc;
            const int nv = (mb < 3) ? ((r == 31) ? snn : snc) : snc;
            float prev0 = __int_as_float(pv << 16), prev1 = __int_as_float(pv & 0xffff0000);
            float next0 = __int_as_float(nv << 16), next1 = __int_as_float(nv & 0xffff0000);
            if (mb == 0 && r == 0) { prev0 = eo0; prev1 = eo1; }
            if (mb == 3 && r == 31) { next0 = eo0; next1 = eo1; }
            spm = spc;
            prev0 *= pm[mb]; prev1 *= pm[mb];
            next0 *= nm[mb]; next1 *= nm[mb];
            u[nb][mb][0] = w0[0] * prev0 + w1[0] * acc[nb][mb][i0] + w2[0] * next0 + bz[0];
            u[nb][mb][1] = w0[1] * prev1 + w1[1] * acc[nb][mb][i0 + 1] + w2[1] * next1 + bz[1];
          }
        }
#pragma unroll
        for (int mb = 0; mb < 4; ++mb)
          *(unsigned*)(ost + (mb * 32 + r) * 40 + ig * 8 + h * 4 + qp * 2) =
              pack2(gelu_tanh(u[1][mb][0]) * u[0][mb][0], gelu_tanh(u[1][mb][1]) * u[0][mb][1]);
      }
    asm volatile("s_waitcnt lgkmcnt(0)" ::: "memory");
    const int lane = h * 32 + r;
#pragma unroll
    for (int j = 0; j < 8; ++j) {
      const int tk = (lane >> 2) + 16 * j, ch = lane & 3;
      const int tr = wm * 128 + tk;
      const int R = row0 + tr;
      const u32x4 v = *(const u32x4*)(ost + tk * 40 + ch * 8);
      if ((tr >= 1) && (tr <= 254) && (R >= 0) && (R < Mrows))
        *(u32x4*)(act + (size_t)R * DFF + nt * 128 + wn * 32 + ch * 8) = v;
    }
    __syncthreads();
  }
};

DI bool tile_map(int id, int NT, int MT, int& mt, int& nt) {
  const int x = id & 7, q = id >> 3;
  nt = q % NT;
  mt = (q / NT) * 8 + x;
  return mt < MT;
}

DI void phase_qkv(const Params& p, int l, char* smem) {
  const int odd = l & 1;
  const int NT = odd ? 6 : 12;
  const u16* W = odd ? (const u16*)(p.ws + OFF_WIN_O) + (size_t)(l >> 1) * 1536 * 1024 : (const u16*)(p.ws + OFF_WIN_E) + (size_t)(l >> 1) * 3072 * 1024;
  const u16* H = (const u16*)(p.ws + OFF_H);
  for (int tile = bid(); tile < 144 * NT; tile += gridDim.x) {
    int mt, nt;
    if (!tile_map(tile, NT, 144, mt, nt)) continue;
    if (l == 3 && mt >= 128 && nt < 4) continue;
    EpiQKV e;
    e.odd = odd; e.row0 = mt * 256; e.ntile = nt;
    e.QO = (u16*)(p.ws + OFF_QO); e.Kb = (u16*)(p.ws + OFF_K); e.VT = (u16*)(p.ws + OFF_VT);
    e.rope = (const f32x2n*)(p.ws + OFF_ROPE);
    e.qkn = p.gqa_qk_norm + (l >> 1) * 128;
    e.ostage = (u16*)smem;
    gemm_tile<4>(H, 1024, mt * 256, NROWS, W + (size_t)nt * 256 * 1024, 1024, 1024, smem, e, tile);
  }
}

struct EpiNull {
  float* sink;
  DI void operator()(f32x16 (&acc)[2][4], int wm, int wn, int r, int h) {
    float s = 0.f;
#pragma unroll
    for (int nb = 0; nb < 2; ++nb)
#pragma unroll
      for (int mb = 0; mb < 4; ++mb)
#pragma unroll
        for (int i = 0; i < 16; ++i) s += acc[nb][mb][i];
    if (s == 123.456f) *sink = s;
  }
};
DI void phase_qkv_null(const Params& p, int l, char* smem) {
  const int odd = l & 1;
  const int NT = odd ? 6 : 12;
  const u16* W = odd ? (const u16*)(p.ws + OFF_WIN_O) + (size_t)(l >> 1) * 1536 * 1024 : (const u16*)(p.ws + OFF_WIN_E) + (size_t)(l >> 1) * 3072 * 1024;
  const u16* H = (const u16*)(p.ws + OFF_H);
  for (int tile = bid(); tile < 144 * NT; tile += gridDim.x) {
    int mt, nt;
    if (!tile_map(tile, NT, 144, mt, nt)) continue;
    EpiNull e;
    e.sink = (float*)(p.ws + OFF_LAM + 64);
    gemm_tile<4>(H, 1024, mt * 256, NROWS, W + (size_t)nt * 256 * 1024, 1024, 1024, smem, e, tile);
  }
}

template <int MB>
DI void phase_res_t(const Params& p, int l, int which, char* smem) {
  constexpr int TR = 64 * MB;
  const int rows = (l == 3) ? NLAT : NROWS;
  const int MT = rows / TR;
  const u16* A = which ? (const u16*)(p.ws + OFF_ACT) : (const u16*)(p.ws + OFF_QO);
  const int lda = which ? DFF : 1024, K = which ? DFF : 1024;
  const u16* W = which ? (const u16*)(p.ws + OFF_WD) + (size_t)l * 1024 * DFF : (const u16*)(p.ws + OFF_WO) + (size_t)l * 1024 * 1024;
  const float* gate = (const float*)(p.ws + OFF_MODS) + (size_t)l * 17 * 6144 + (which ? 5 : 2) * 1024;
  for (int tile = bid(); tile < MT * 4; tile += gridDim.x) {
    int mt, nt;
    if (!tile_map(tile, 4, MT, mt, nt)) continue;
    EpiRes<MB> e;
    e.X = (_Float16*)(p.ws + OFF_X); e.gate = gate; e.row0 = mt * TR; e.n0 = nt * 256; e.ostage = (u16*)smem;
    gemm_tile<MB>(A, lda, mt * TR, rows, W + (size_t)nt * 256 * K, K, K, smem, e, tile);
  }
}
DI void phase_res(const Params& p, int l, int which, char* smem) {
  if (l == 3) phase_res_t<4>(p, l, which, smem);
  else phase_res_t<3>(p, l, which, smem);
}

DI void phase_up(const Params& p, int l, char* smem) {
  const int rows = (l == 3) ? NLAT : NROWS;
  const int MT = (rows + 253) / 254;
  const int MTP = (MT + 7) & ~7;
  const u16* W = (const u16*)(p.ws + OFF_WUP) + (size_t)l * 5632 * 1024;
  const u16* H = (const u16*)(p.ws + OFF_H);
  for (int tile = bid(); tile < MTP * 22; tile += gridDim.x) {
    int mt, nt;
    if (!tile_map(tile, 22, MT, mt, nt)) continue;
    EpiUp e;
    e.act = (u16*)(p.ws + OFF_ACT); e.cw = p.conv_w + (size_t)l * 3 * 5632; e.cb = p.conv_b + (size_t)l * 5632;
    e.row0 = mt * 254 - 1; e.Mrows = rows; e.nt = nt; e.edge = (float*)(smem + 131072); e.ostage = (u16*)smem;
    gemm_tile<4>(H, 1024, mt * 254 - 1, rows, W + (size_t)nt * 256 * 1024, 1024, 1024, smem, e, tile);
  }
}

struct AttnArgs {
  u16* qo;
  const u16 *k1, *k2, *vt;
  int s0, n0, n1;
  const float* rpb;
  int rq0, us;
  float lam, oml;
  const float* subln;
};

template <int DV, int MODE>
DI void attn_item(const AttnArgs& a, char* smem) {
  u16* Ks1 = (u16*)smem;
  u16* Ks2 = (u16*)(smem + 9216);
  u16* Vs = (u16*)(smem + 18432);
  float* rpbS = (float*)(smem + 36864);
  const int t = tid(), lane = t & 63, w = __builtin_amdgcn_readfirstlane(t >> 6), r = lane & 31, h = lane >> 5;
  constexpr int NDV = DV / 32;
  constexpr int NVL = DV / 64;
  const int nt = a.n0 + a.n1;

  const int qrow = (MODE == 1) ? ((w & 3) * 32 + r) : (w * 32 + r);
  const int qcoff = (MODE == 1) ? ((w >> 2) * 64) : 0;
  u16* qp = a.qo + (size_t)qrow * 1024;
  bf8 qf[4];
#pragma unroll
  for (int ks = 0; ks < 4; ++ks) qf[ks] = *(const bf8*)(qp + qcoff + ks * 16 + h * 8);
  const u16* Ks = (MODE == 1 && (w >> 2)) ? Ks2 : Ks1;

  int rq = 0, qc = 0, cs = 0, rsw = 0;
  if (MODE == 2) {
    __syncthreads();
    for (int e = t; e < 15 * 32; e += NTHR) {
      const int dr = e >> 5, dc = e & 31;
      rpbS[e] = (dc < 31) ? a.rpb[dr * 31 + dc] * LOG2E : 0.f;
    }
    rq = a.rq0 + (w >> 1);
    qc = (w & 1) * 32 + r;
    cs = qc - 8; cs = cs < 0 ? 0 : (cs > 48 ? 48 : cs);
    rsw = rq - 4; rsw = rsw < 0 ? 0 : (rsw > 24 ? 24 : rsw);
  }

  f32x16 O[NDV];
#pragma unroll
  for (int d = 0; d < NDV; ++d)
#pragma unroll
    for (int i = 0; i < 16; ++i) O[d][i] = 0.f;
  float m = -1e30f, lsum = 0.f;

  u32x4 rk1, rk2, rv[NVL];
  const int srow = t >> 3, sch = t & 7;
#define ATTN_FETCH(TT)                                                                                         \
  {                                                                                                            \
    const int tt_ = (TT);                                                                                      \
    const int key0_ = tt_ < a.n0 ? a.s0 + tt_ * 64 : 2048 + (tt_ - a.n0) * 64;                                 \
    rk1 = *(const u32x4*)(a.k1 + (size_t)(key0_ + srow) * 64 + sch * 8);                                       \
    if (MODE == 1) rk2 = *(const u32x4*)(a.k2 + (size_t)(key0_ + srow) * 64 + sch * 8);                        \
    _Pragma("unroll") for (int j = 0; j < NVL; ++j)                                                            \
        rv[j] = *(const u32x4*)(a.vt + (size_t)(srow + 64 * j) * T + key0_ + sch * 8);                         \
  }
  if (nt > 0) ATTN_FETCH(0)
  for (int tt = 0; tt < nt; ++tt) {
    __syncthreads();
    *(u32x4*)(Ks1 + srow * 72 + sch * 8) = rk1;
    if (MODE == 1) *(u32x4*)(Ks2 + srow * 72 + sch * 8) = rk2;
#pragma unroll
    for (int j = 0; j < NVL; ++j) *(u32x4*)(Vs + (srow + 64 * j) * 72 + sch * 8) = rv[j];
    __syncthreads();
    if (tt + 1 < nt) ATTN_FETCH(tt + 1)
    __builtin_amdgcn_sched_barrier(0);

    bool active = true;
    int kr = 0;
    const bool local = (MODE == 2) && (tt < a.n0);
    if (local) { kr = a.us + tt; active = (kr >= rsw) && (kr < rsw + 8); }
    if (active) {
      f32x16 s[2];
#pragma unroll
      for (int kb = 0; kb < 2; ++kb) {
#pragma unroll
        for (int i = 0; i < 16; ++i) s[kb][i] = 0.f;
#pragma unroll
        for (int ks = 0; ks < 4; ++ks) {
          const bf8 kf = *(const bf8*)(Ks + (kb * 32 + r) * 72 + ks * 16 + h * 8);
          s[kb] = mfma32(kf, qf[ks], s[kb]);
        }
      }
      constexpr float SC = 0.125f * LOG2E;
      float mx = -INFINITY;
      if (local) {
#pragma unroll
        for (int kb = 0; kb < 2; ++kb)
#pragma unroll
          for (int i = 0; i < 16; ++i) {
            const int kc = kb * 32 + crow(i, h);
            const bool ok = (kc >= cs) && (kc < cs + 16);
            const int dc = kc - qc + 15;
            const int dr = kr - rq + 7;
            const float bias = rpbS[dr * 32 + (ok ? dc : 0)];
            const float v = ok ? (s[kb][i] + bias * (1.f / SC)) : -INFINITY;
            s[kb][i] = v;
            mx = fmaxf(mx, v);
          }
      } else {
#pragma unroll
        for (int kb = 0; kb < 2; ++kb)
#pragma unroll
          for (int i = 0; i < 16; i += 2) mx = fmaxf(fmaxf(mx, s[kb][i]), s[kb][i + 1]);
      }
      mx = fmaxf(mx, shx(mx, lane, 32)) * SC;
      const float mn = fmaxf(m, mx);
      const bool resc = __builtin_amdgcn_ballot_w64(mn != m) != 0ull;
      float ps0 = 0.f, ps1 = 0.f;
#pragma unroll
      for (int kb = 0; kb < 2; ++kb)
#pragma unroll
        for (int i = 0; i < 16; i += 2) {
          f32x2n v = {s[kb][i], s[kb][i + 1]};
          v = v * f32x2n{SC, SC} - f32x2n{mn, mn};
          const float p0 = ex2(v.x), p1 = ex2(v.y);
          s[kb][i] = p0; s[kb][i + 1] = p1;
          ps0 += p0; ps1 += p1;
        }
      if (resc) {
        const float alpha = ex2(m - mn);
        m = mn;
        lsum *= alpha;
#pragma unroll
        for (int d = 0; d < NDV; ++d)
#pragma unroll
          for (int i = 0; i < 16; ++i) O[d][i] *= alpha;
      }
      lsum += ps0 + ps1;
#pragma unroll
      for (int kb = 0; kb < 2; ++kb)
#pragma unroll
        for (int s2 = 0; s2 < 2; ++s2) {
          u32x4 pk;
          pk.x = pack2(s[kb][s2 * 8 + 0], s[kb][s2 * 8 + 1]);
          pk.y = pack2(s[kb][s2 * 8 + 2], s[kb][s2 * 8 + 3]);
          pk.z = pack2(s[kb][s2 * 8 + 4], s[kb][s2 * 8 + 5]);
          pk.w = pack2(s[kb][s2 * 8 + 6], s[kb][s2 * 8 + 7]);
          const bf8 pf = __builtin_bit_cast(bf8, pk);
#pragma unroll
          for (int d = 0; d < NDV; ++d) {
            const u16* vp = Vs + (d * 32 + r) * 72 + kb * 32 + s2 * 16 + 4 * h;
            u32x4 vv;
            const u32x2 lo = *(const u32x2*)(vp);
            const u32x2 hi = *(const u32x2*)(vp + 8);
            vv.x = lo.x; vv.y = lo.y; vv.z = hi.x; vv.w = hi.y;
            O[d] = mfma32(__builtin_bit_cast(bf8, vv), pf, O[d]);
          }
        }
    }
  }
  const float ltot = lsum + shx(lsum, lane, 32);
  const float inv = 1.f / ltot;
  if (MODE != 1) {
#pragma unroll
    for (int d = 0; d < NDV; ++d)
#pragma unroll
      for (int ig = 0; ig < 4; ++ig) {
        u32x2 o;
        o.x = pack2(O[d][ig * 4 + 0] * inv, O[d][ig * 4 + 1] * inv);
        o.y = pack2(O[d][ig * 4 + 2] * inv, O[d][ig * 4 + 3] * inv);
        *(u32x2*)(qp + d * 32 + ig * 8 + h * 4) = o;
      }
  } else {
    float* comb = (float*)smem;
    __syncthreads();
    if (w >= 4) {
#pragma unroll
      for (int d = 0; d < NDV; ++d)
#pragma unroll
        for (int i = 0; i < 16; ++i) comb[((w - 4) * 128 + d * 32 + crow(i, h)) * 32 + r] = O[d][i] * inv;
    }
    __syncthreads();
    if (w < 4) {
      float ss = 0.f;
#pragma unroll
      for (int d = 0; d < NDV; ++d)
#pragma unroll
        for (int i = 0; i < 16; ++i) {
          const float o = O[d][i] * inv - a.lam * comb[(w * 128 + d * 32 + crow(i, h)) * 32 + r];
          O[d][i] = o;
          ss += o * o;
        }
      ss += shx(ss, lane, 32);
      const float rs = rsqrtf(ss * (1.f / 128.f) + EPS) * a.oml;
#pragma unroll
      for (int d = 0; d < NDV; ++d)
#pragma unroll
        for (int ig = 0; ig < 4; ++ig) {
          const f32x4n gv = *(const f32x4n*)(a.subln + d * 32 + ig * 8 + h * 4);
          u32x2 o;
          o.x = pack2(O[d][ig * 4 + 0] * rs * gv.x, O[d][ig * 4 + 1] * rs * gv.y);
          o.y = pack2(O[d][ig * 4 + 2] * rs * gv.z, O[d][ig * 4 + 3] * rs * gv.w);
          *(u32x2*)(qp + d * 32 + ig * 8 + h * 4) = o;
        }
    }
  }
}

DI void attn_item_q64(const AttnArgs& a, char* smem) {
  char* Kb_ = smem;
  char* Vb_ = smem + 16384;
  const unsigned lds_base = (unsigned)(size_t)(lds_char*)smem;
  const int t = tid(), lane = t & 63, w = __builtin_amdgcn_readfirstlane(t >> 6), r = lane & 31, h = lane >> 5;
  const int nt = a.n0 + a.n1;
  u16* qp[2];
  bf8 qf[2][4];
#pragma unroll
  for (int q2 = 0; q2 < 2; ++q2) {
    qp[q2] = a.qo + (size_t)(w * 64 + q2 * 32 + r) * 1024;
#pragma unroll
    for (int ks = 0; ks < 4; ++ks) qf[q2][ks] = *(const bf8*)(qp[q2] + ks * 16 + h * 8);
  }
  f32x16 O[2][2];
#pragma unroll
  for (int q2 = 0; q2 < 2; ++q2)
#pragma unroll
    for (int d = 0; d < 2; ++d)
#pragma unroll
      for (int i = 0; i < 16; ++i) O[q2][d][i] = 0.f;
  float m[2] = {-1e30f, -1e30f}, lsum[2] = {0.f, 0.f};
  const int srow = t >> 3, sch = (t & 7) ^ ((srow >> 1) & 7);
  const u16* kg = a.k1 + (size_t)srow * 64 + sch * 8;
  const u16* vg = a.vt + (size_t)srow * T + sch * 8;
#define ATTN2_ISSUE(TT, BUF)                                                                                   \
  {                                                                                                            \
    const int tt_ = (TT) < nt ? (TT) : nt - 1;                                                                 \
    const int key0_ = tt_ < a.n0 ? a.s0 + tt_ * 64 : 2048 + (tt_ - a.n0) * 64;                                 \
    glds16(kg + (size_t)key0_ * 64, lds_base + (BUF) * 8192 + w * 1024);                                       \
    glds16(vg + key0_, lds_base + 16384 + (BUF) * 8192 + w * 1024);                                            \
  }
  __syncthreads();
  ATTN2_ISSUE(0, 0)
  ATTN2_ISSUE(1, 1)
  asm volatile("s_waitcnt vmcnt(2)" ::: "memory");
  __syncthreads();
  const int sw = (r >> 1) & 7;
  int koff[4];
#pragma unroll
  for (int ks = 0; ks < 4; ++ks) koff[ks] = r * 128 + (((2 * ks + h) ^ sw) << 4);
  for (int tt = 0; tt < nt; ++tt) {
    const char* Ks = Kb_ + (tt & 1) * 8192;
    const char* Vs = Vb_ + (tt & 1) * 8192;
    f32x16 s[2][2];
#pragma unroll
    for (int kb = 0; kb < 2; ++kb) {
#pragma unroll
      for (int q2 = 0; q2 < 2; ++q2)
#pragma unroll
        for (int i = 0; i < 16; ++i) s[q2][kb][i] = 0.f;
#pragma unroll
      for (int ks = 0; ks < 4; ++ks) {
        const bf8 kf = *(const bf8*)(Ks + kb * 32 * 128 + koff[ks]);
#pragma unroll
        for (int q2 = 0; q2 < 2; ++q2) s[q2][kb] = mfma32(kf, qf[q2][ks], s[q2][kb]);
      }
    }
    constexpr float SC = 0.125f * LOG2E;
#pragma unroll
    for (int q2 = 0; q2 < 2; ++q2) {
      float mx = -INFINITY;
#pragma unroll
      for (int kb = 0; kb < 2; ++kb)
#pragma unroll
        for (int i = 0; i < 16; i += 2) mx = fmaxf(fmaxf(mx, s[q2][kb][i]), s[q2][kb][i + 1]);
      mx = fmaxf(mx, shx(mx, lane, 32)) * SC;
      const float mn = fmaxf(m[q2], mx);
      const bool resc = __builtin_amdgcn_ballot_w64(mn != m[q2]) != 0ull;
      float ps0 = 0.f, ps1 = 0.f;
#pragma unroll
      for (int kb = 0; kb < 2; ++kb)
#pragma unroll
        for (int i = 0; i < 16; i += 2) {
          f32x2n v = {s[q2][kb][i], s[q2][kb][i + 1]};
          v = v * f32x2n{SC, SC} - f32x2n{mn, mn};
          const float p0 = ex2(v.x), p1 = ex2(v.y);
          s[q2][kb][i] = p0; s[q2][kb][i + 1] = p1;
          ps0 += p0; ps1 += p1;
        }
      if (resc) {
        const float alpha = ex2(m[q2] - mn);
        m[q2] = mn;
        lsum[q2] *= alpha;
#pragma unroll
        for (int d = 0; d < 2; ++d)
#pragma unroll
          for (int i = 0; i < 16; ++i) O[q2][d][i] *= alpha;
      }
      lsum[q2] += ps0 + ps1;
    }
#pragma unroll
    for (int kb = 0; kb < 2; ++kb)
#pragma unroll
      for (int s2 = 0; s2 < 2; ++s2) {
        const int kk = kb * 2 + s2;
        bf8 pf[2];
#pragma unroll
        for (int q2 = 0; q2 < 2; ++q2) {
          u32x4 pk;
          pk.x = pack2(s[q2][kb][s2 * 8 + 0], s[q2][kb][s2 * 8 + 1]);
          pk.y = pack2(s[q2][kb][s2 * 8 + 2], s[q2][kb][s2 * 8 + 3]);
          pk.z = pack2(s[q2][kb][s2 * 8 + 4], s[q2][kb][s2 * 8 + 5]);
          pk.w = pack2(s[q2][kb][s2 * 8 + 6], s[q2][kb][s2 * 8 + 7]);
          pf[q2] = __builtin_bit_cast(bf8, pk);
        }
#pragma unroll
        for (int d = 0; d < 2; ++d) {
          const char* vrow = Vs + (d * 32 + r) * 128 + 8 * h;
          u32x4 vv;
          const u32x2 lo = *(const u32x2*)(vrow + (((2 * kk) ^ sw) << 4));
          const u32x2 hi = *(const u32x2*)(vrow + (((2 * kk + 1) ^ sw) << 4));
          vv.x = lo.x; vv.y = lo.y; vv.z = hi.x; vv.w = hi.y;
          const bf8 vf = __builtin_bit_cast(bf8, vv);
#pragma unroll
          for (int q2 = 0; q2 < 2; ++q2) O[q2][d] = mfma32(vf, pf[q2], O[q2][d]);
        }
      }
    asm volatile("s_waitcnt vmcnt(0)" ::: "memory");
    __syncthreads();
    if (tt + 2 < nt) ATTN2_ISSUE(tt + 2, tt & 1)
  }
#pragma unroll
  for (int q2 = 0; q2 < 2; ++q2) {
    const float ltot = lsum[q2] + shx(lsum[q2], lane, 32);
    const float inv = 1.f / ltot;
#pragma unroll
    for (int d = 0; d < 2; ++d)
#pragma unroll
      for (int ig = 0; ig < 4; ++ig) {
        u32x2 o;
        o.x = pack2(O[q2][d][ig * 4 + 0] * inv, O[q2][d][ig * 4 + 1] * inv);
        o.y = pack2(O[q2][d][ig * 4 + 2] * inv, O[q2][d][ig * 4 + 3] * inv);
        *(u32x2*)(qp[q2] + d * 32 + ig * 8 + h * 4) = o;
      }
  }
}

DI void phase_attn(const Params& p, int l, char* smem) {
  u16* QO = (u16*)(p.ws + OFF_QO);
  const u16* Kb = (const u16*)(p.ws + OFF_K);
  const u16* VT = (const u16*)(p.ws + OFF_VT);
  const bool need_ctx = l < 3;
  if (l & 1) {
    const int total = 1024 + (need_ctx ? 256 : 0);
    for (int id = bid(); id < total; id += gridDim.x) {
      AttnArgs a;
      a.k2 = nullptr; a.rpb = nullptr; a.rq0 = 0; a.us = 0; a.lam = 0.f; a.oml = 0.f; a.subln = nullptr;
      if (id < 1024) {
        const int x = id & 7, q = id >> 3, within = q & 15, g = (q >> 4) * 8 + x;
        const int b = g >> 2, kvh = g & 3, hq = kvh * 4 + (within >> 2), qb = within & 3;
        a.qo = QO + (size_t)(b * 2048 + qb * 512) * 1024 + hq * 64;
        a.k1 = Kb + ((size_t)b * 4 + kvh) * T * 64;
        a.vt = VT + ((size_t)b * 256 + kvh * 64) * T;
        a.s0 = 0; a.n0 = 32; a.n1 = 4;
        attn_item_q64(a, smem);
        continue;
      } else {
        const int id2 = id - 1024;
        const int hq = id2 & 15, b = id2 >> 4, kvh = hq >> 2;
        a.qo = QO + (size_t)(NLAT + b * 256) * 1024 + hq * 64;
        a.k1 = Kb + ((size_t)b * 4 + kvh) * T * 64;
        a.vt = VT + ((size_t)b * 256 + kvh * 64) * T;
        a.s0 = 0; a.n0 = 0; a.n1 = 4;
      }
      attn_item<64, 0>(a, smem);
    }
  } else {
    const int li = l >> 1;
    const float lam = ((const float*)(p.ws + OFF_LAM))[li];
    const float oml = 1.f - ((li == 0) ? 0.2f : 0.47071301834358393f);
    const int total = 1024 + 1024 + (need_ctx ? 128 + 128 : 0);
    for (int id = bid(); id < total; id += gridDim.x) {
      AttnArgs a;
      a.k2 = nullptr; a.rpb = nullptr; a.rq0 = 0; a.us = 0; a.lam = lam; a.oml = oml; a.subln = p.diff_subln + li * 128;
      if (id < 1024) {
        const int x = id & 7, q = id >> 3, qb = q & 15, g = (q >> 4) * 8 + x;
        const int b = g >> 2, j = g & 3;
        a.qo = QO + (size_t)(b * 2048 + qb * 128) * 1024 + 512 + j * 128;
        a.k1 = Kb + ((size_t)b * 16 + 8 + 2 * j) * T * 64;
        a.k2 = Kb + ((size_t)b * 16 + 8 + 2 * j + 1) * T * 64;
        a.vt = VT + ((size_t)b * 1024 + 512 + j * 128) * T;
        a.s0 = 0; a.n0 = 32; a.n1 = 4;
        attn_item<128, 1>(a, smem);
      } else if (id < 2048) {
        const int id2 = id - 1024;
        const int x = id2 & 7, q = id2 >> 3, pr = q & 7, g = (q >> 3) * 8 + x;
        const int b = g >> 3, hd = g & 7;
        const int r0 = 4 * pr;
        int rs0 = r0 - 4; rs0 = rs0 < 0 ? 0 : (rs0 > 24 ? 24 : rs0);
        int rs3 = r0 - 1; rs3 = rs3 < 0 ? 0 : (rs3 > 24 ? 24 : rs3);
        a.qo = QO + (size_t)(b * 2048 + r0 * 64) * 1024 + hd * 64;
        a.k1 = Kb + ((size_t)b * 16 + hd) * T * 64;
        a.vt = VT + ((size_t)b * 1024 + hd * 64) * T;
        a.s0 = rs0 * 64; a.n0 = rs3 + 8 - rs0; a.n1 = 4;
        a.rpb = p.na_rpb + ((size_t)li * 8 + hd) * 15 * 31;
        a.rq0 = r0; a.us = rs0;
        attn_item<64, 2>(a, smem);
      } else if (id < 2048 + 128) {
        const int g = id - 2048, b = g >> 3, hd = g & 7;
        a.qo = QO + (size_t)(NLAT + b * 256) * 1024 + hd * 64;
        a.k1 = Kb + ((size_t)b * 16 + hd) * T * 64;
        a.vt = VT + ((size_t)b * 1024 + hd * 64) * T;
        a.s0 = 0; a.n0 = 0; a.n1 = 4;
        attn_item<64, 0>(a, smem);
      } else {
        const int id2 = id - 2048 - 128;
        const int qb = id2 & 1, g = id2 >> 1, b = g >> 2, j = g & 3;
        a.qo = QO + (size_t)(NLAT + b * 256 + qb * 128) * 1024 + 512 + j * 128;
        a.k1 = Kb + ((size_t)b * 16 + 8 + 2 * j) * T * 64;
        a.k2 = Kb + ((size_t)b * 16 + 8 + 2 * j + 1) * T * 64;
        a.vt = VT + ((size_t)b * 1024 + 512 + j * 128) * T;
        a.s0 = 0; a.n0 = 0; a.n1 = 4;
        attn_item<128, 1>(a, smem);
      }
    }
  }
}

constexpr int N_PHASES = 30;
DI void run_phase(const Params& p, int ph, char* smem) {
  if (ph == 0) {
    phase0_mods(p, smem);
    phase0_weights(p, smem, 0);
    phase0_misc(p);
    return;
  }
  if (ph == 29) { phase_final(p); return; }
  const int l = (ph - 1) / 7, s = (ph - 1) % 7;
  switch (s) {
    case 0: phase_prep(p, l, 0); break;
    case 1: phase_qkv(p, l, smem); break;
    case 2: phase_attn(p, l, smem); break;
    case 3: phase_res(p, l, 0, smem); break;
    case 4: phase_prep(p, l, 1); break;
    case 5: phase_up(p, l, smem); break;
    default: phase_res(p, l, 1, smem); break;
  }
}

#if MK_MULTI
__global__ void __launch_bounds__(512, 2) fwd_megakernel(Params p, int ph_lo, int ph_hi) {
  __shared__ __attribute__((aligned(16))) char smem[SMEM_BYTES];
  for (int ph = ph_lo; ph < ph_hi; ++ph) run_phase(p, ph, smem);
}
#else
#if USE_XCD_BARRIER
#define GRID_BARRIER() xcd_barrier(xb)
#else
#define GRID_BARRIER() grid.sync()
#endif
__global__ void __launch_bounds__(512, 2) fwd_megakernel(Params p, int ph_lo, int ph_hi) {
  __shared__ __attribute__((aligned(16))) char smem[SMEM_BYTES];
  __shared__ __attribute__((aligned(16))) unsigned xb_words[4];
  cg::grid_group grid = cg::this_grid();
  if (threadIdx.x < 4) xb_words[threadIdx.x] = 0u;
  __syncthreads();
  const XcdBarrier xb = xcd_barrier_post((unsigned*)(p.ws + OFF_BAR), (volatile LAS unsigned*)xb_words);
  phase0_mods(p, smem);
  phase0_weights(p, smem, 0);
  phase0_misc(p);
  if (p.out == nullptr) grid.sync();
  GRID_BARRIER();
#pragma unroll 1
  for (int l = 0; l < 4; ++l) {
    phase_prep(p, l, 0);
    GRID_BARRIER();
#if PROBE == 1
    phase_qkv(p, l, smem);
    GRID_BARRIER();
    phase_attn(p, l, smem);
    GRID_BARRIER();
#endif
#if PROBE == 2
    phase_qkv(p, l, smem);
    GRID_BARRIER();
#endif
#if PROBE == 4
    phase_qkv_null(p, l, smem);
    GRID_BARRIER();
#endif
#if PROBE == 5
    GRID_BARRIER(); GRID_BARRIER(); GRID_BARRIER(); GRID_BARRIER(); GRID_BARRIER(); GRID_BARRIER(); GRID_BARRIER();
#endif
    phase_qkv(p, l, smem);
    GRID_BARRIER();
    if (l == 0 && (bid() & 1)) phase0_weights(p, smem, 1);
    phase_attn(p, l, smem);
    if (l == 0 && !(bid() & 1)) phase0_weights(p, smem, 1);
    GRID_BARRIER();
    phase_res(p, l, 0, smem);
    GRID_BARRIER();
    phase_prep(p, l, 1);
    GRID_BARRIER();
#if PROBE == 3
    phase_up(p, l, smem);
    GRID_BARRIER();
#endif
    phase_up(p, l, smem);
    GRID_BARRIER();
    phase_res(p, l, 1, smem);
    GRID_BARRIER();
  }
  phase_final(p);
}
#endif

extern "C" void kernel_launch(void* const* d_in, const int* in_sizes, int n_in, void* d_out, int out_size, void* d_ws, size_t ws_size,
                              hipStream_t stream) {
  static int grid_blocks = 0;
  if (!grid_blocks) {
    int dev = 0, cus = 0, per_cu = 0;
    hipGetDevice(&dev);
    hipDeviceGetAttribute(&cus, hipDeviceAttributeMultiprocessorCount, dev);
    hipOccupancyMaxActiveBlocksPerMultiprocessor(&per_cu, fwd_megakernel, NTHR, 0);
    per_cu = 1;
    grid_blocks = cus * per_cu;
  }
  if (ws_size < WS_NEEDED) fprintf(stderr, "workspace too small: %zu < %zu\n", ws_size, (size_t)WS_NEEDED);
  Params p{};
  p.x = (const float*)d_in[0]; p.c = (const float*)d_in[1]; p.ctx = (const float*)d_in[2]; p.c_ctx = (const float*)d_in[3];
  p.w_ada = (const float*)d_in[4]; p.b_ada = (const float*)d_in[5]; p.ln_g = (const float*)d_in[6]; p.ln_b = (const float*)d_in[7];
  p.w_in_ab = (const float*)d_in[8]; p.w_o_ab = (const float*)d_in[9]; p.na_rpb = (const float*)d_in[10];
  p.diff_lambda = (const float*)d_in[11]; p.diff_subln = (const float*)d_in[12]; p.w_in_c = (const float*)d_in[13];
  p.w_o_c = (const float*)d_in[14]; p.gqa_qk_norm = (const float*)d_in[15]; p.w_up = (const float*)d_in[16];
  p.conv_w = (const float*)d_in[17]; p.conv_b = (const float*)d_in[18]; p.w_down = (const float*)d_in[19];
  p.out = (float*)d_out;
  p.ws = (char*)d_ws;
  hipMemsetAsync((char*)d_ws + OFF_BAR, 0, 16384, stream);
#if MK_MULTI
  for (int ph = 0; ph < N_PHASES; ++ph) {
    hipLaunchKernelGGL(fwd_megakernel, dim3(grid_blocks), dim3(NTHR), 0, stream, p, ph, ph + 1);
  }
#else
  int lo = 0, hi = N_PHASES;
  void* args[] = {&p, &lo, &hi};
  hipError_t e = hipLaunchCooperativeKernel((void*)fwd_megakernel, dim3(grid_blocks), dim3(NTHR), args, 0, stream);
  if (e != hipSuccess) fprintf(stderr, "cooperative launch failed: %s (grid %d)\n", hipGetErrorString(e), grid_blocks);
#endif
}
```
